# Optimizing an MI355X kernel written in HIP

```python
import math
import jax, jax.numpy as jnp
from jax import lax
import numpy as np

D_MODEL = 2048
BATCH = 2
SEQ = 4096
DEPTH = 1
DEC_BATCH = 128
DEC_SEQ = 4
PAST_LEN = 16384
PAGE_SIZE = 128

SSM_WIDTH = D_MODEL // 2
GROUP_CH = 16
N_GROUPS = SSM_WIDTH // GROUP_CH
STATE_DIM = 64
HEAD_DIM = 64
N_HEADS = (D_MODEL // 2) // HEAD_DIM
N_KV_HEADS = 4
KV_GROUP = N_HEADS // N_KV_HEADS
ATTN_WIDTH = N_HEADS * HEAD_DIM
KV_WIDTH = N_KV_HEADS * HEAD_DIM
WINDOW = 128
NUM_BUCKETS = 32
MAX_DISTANCE = 128
FFN_HIDDEN = -(-8 * D_MODEL // (3 * 256)) * 256
IN_SPLITS = [SSM_WIDTH, ATTN_WIDTH, KV_WIDTH, KV_WIDTH, 2 * D_MODEL]
IN_COLS = sum(IN_SPLITS)
EPS = 1e-6
NEG_INF = -1e30

kernel_name = 'hybrid_s5_swa_sink_gated_decoder_step'


def rmsnorm(x, g):
    xf = x.astype(jnp.float32)
    y = xf * lax.rsqrt(jnp.mean(xf * xf, axis=-1, keepdims=True) + EPS)
    return (y * g.astype(jnp.float32)).astype(x.dtype)


def t5_bucket(dist):
    n = np.maximum(dist, 0)
    max_exact = NUM_BUCKETS // 2
    large = max_exact + (np.log(np.maximum(n, 1) / max_exact) / np.log(MAX_DISTANCE / max_exact)
                         * (NUM_BUCKETS - max_exact)).astype(np.int32)
    large = np.minimum(large, NUM_BUCKETS - 1)
    return np.where(n < max_exact, n, large).astype(np.int32)


def _complex_affine_combine(e1, e2):
    a1r, a1i, b1r, b1i = e1
    a2r, a2i, b2r, b2i = e2
    ar = a1r * a2r - a1i * a2i
    ai = a1r * a2i + a1i * a2r
    br = a2r * b1r - a2i * b1i + b2r
    bi = a2r * b1i + a2i * b1r + b2i
    return (ar, ai, br, bi)


def ssm_scan(u, h0_re, h0_im, lam_re, lam_im, log_dt, b_re, b_im, c_re, c_im, d_skip):
    f32 = jnp.float32
    n, L = u.shape[:2]
    lr = jnp.minimum(lam_re.astype(f32), -1e-4)
    li = lam_im.astype(f32)
    dt = jnp.exp(log_dt.astype(f32))[:, None]
    mag = jnp.exp(lr * dt)
    a_re = mag * jnp.cos(li * dt)
    a_im = mag * jnp.sin(li * dt)
    den = lr * lr + li * li
    coef_re = ((a_re - 1.0) * lr + a_im * li) / den
    coef_im = (a_im * lr - (a_re - 1.0) * li) / den
    uf = u.astype(f32)
    bu_re = jnp.einsum('nlgc,gpc->nlgp', uf, b_re.astype(f32))
    bu_im = jnp.einsum('nlgc,gpc->nlgp', uf, b_im.astype(f32))
    x_re = coef_re * bu_re - coef_im * bu_im
    x_im = coef_re * bu_im + coef_im * bu_re
    shp = x_re.shape
    elems = (jnp.broadcast_to(a_re, shp), jnp.broadcast_to(a_im, shp), x_re, x_im)
    acum_re, acum_im, h_re, h_im = lax.associative_scan(_complex_affine_combine, elems, axis=1)
    if h0_re is not None:
        s_re = h0_re.astype(f32)[:, None]
        s_im = h0_im.astype(f32)[:, None]
        h_re, h_im = (h_re + acum_re * s_re - acum_im * s_im,
                      h_im + acum_re * s_im + acum_im * s_re)
    y = (jnp.einsum('nlgp,gcp->nlgc', h_re, c_re.astype(f32))
         - jnp.einsum('nlgp,gcp->nlgc', h_im, c_im.astype(f32))
         + d_skip.astype(f32).reshape(N_GROUPS, GROUP_CH) * uf)
    return y.reshape(n, L, SSM_WIDTH), h_re[:, -1], h_im[:, -1]


def window_attention(q, k, v, dist, valid, rel_bias, sinks):
    lead = q.shape[:-3]
    nq = q.shape[-3]
    qg = q.reshape(*lead, nq, N_KV_HEADS, KV_GROUP, HEAD_DIM)
    s = jnp.einsum('...qhgd,...khd->...hgqk', qg, k,
                   preferred_element_type=jnp.float32) * (HEAD_DIM ** -0.5)
    bias = rel_bias.astype(jnp.float32)[t5_bucket(dist)]
    bias = jnp.transpose(bias, (2, 0, 1)).reshape(N_KV_HEADS, KV_GROUP, *dist.shape)
    s = jnp.where(valid, s + bias, NEG_INF)
    sink = jnp.broadcast_to(sinks.astype(jnp.float32).reshape(N_KV_HEADS, KV_GROUP, 1, 1),
                            s.shape[:-1] + (1,))
    p = jax.nn.softmax(jnp.concatenate([s, sink], axis=-1), axis=-1)[..., :-1]
    o = jnp.einsum('...hgqk,...khd->...qhgd', p.astype(v.dtype), v)
    return o.reshape(*lead, nq, ATTN_WIDTH)


def prompt_window_attention(q, k, v, rel_bias, sinks):
    b, L = q.shape[:2]
    nb = L // WINDOW
    qb = q.reshape(b, nb, WINDOW, N_HEADS, HEAD_DIM)
    kb = k.reshape(b, nb, WINDOW, N_KV_HEADS, HEAD_DIM)
    vb = v.reshape(b, nb, WINDOW, N_KV_HEADS, HEAD_DIM)
    pad_k = jnp.zeros_like(kb[:, :1])
    pad_v = jnp.zeros_like(vb[:, :1])
    kk = jnp.concatenate([jnp.concatenate([pad_k, kb[:, :-1]], axis=1), kb], axis=2)
    vv = jnp.concatenate([jnp.concatenate([pad_v, vb[:, :-1]], axis=1), vb], axis=2)
    i = np.arange(WINDOW)[:, None]
    j = np.arange(2 * WINDOW)[None, :]
    dist = i + WINDOW - j
    kpos = (np.arange(nb)[:, None, None] - 1) * WINDOW + j
    valid = (dist >= 0) & (dist < WINDOW) & (kpos >= 0)
    o = window_attention(qb, kk, vv, dist, valid[:, None, None], rel_bias, sinks)
    return o.reshape(b, L, ATTN_WIDTH)


def sample_window_attention(q, k, v, k_buf, v_buf, rel_bias, sinks):
    w_buf = k_buf.shape[1]
    nq = q.shape[1]
    kk = jnp.concatenate([k_buf.astype(k.dtype), k], axis=1)
    vv = jnp.concatenate([v_buf.astype(v.dtype), v], axis=1)
    dist = np.arange(nq)[:, None] + w_buf - np.arange(w_buf + nq)[None, :]
    valid = (dist >= 0) & (dist < WINDOW)
    o = window_attention(q, kk, vv, dist, valid, rel_bias, sinks)
    return o, kk[:, -w_buf:], vv[:, -w_buf:]


def decoder_layer(x, h0_re, h0_im, k_buf, v_buf, rel_bias,
                  norm_attn, w_in, lam_re, lam_im, log_dt, b_re, b_im, c_re, c_im, d_skip,
                  w_glu_val, w_glu_gate, w_attn_br, sinks, w_out, norm_ffn, w_ffn_in, w_ffn_out):
    n, L, _ = x.shape
    h = rmsnorm(x, norm_attn)
    proj = h @ w_in
    u, q, k, v, gates = jnp.split(proj, list(np.cumsum(IN_SPLITS)[:-1]), axis=-1)
    y, st_re, st_im = ssm_scan(u.reshape(n, L, N_GROUPS, GROUP_CH), h0_re, h0_im,
                               lam_re, lam_im, log_dt, b_re, b_im, c_re, c_im, d_skip)
    g = jax.nn.gelu(y).astype(x.dtype)
    a_out = (g @ w_glu_val) * jax.nn.sigmoid(g @ w_glu_gate)
    q = q.reshape(n, L, N_HEADS, HEAD_DIM)
    k = k.reshape(n, L, N_KV_HEADS, HEAD_DIM)
    v = v.reshape(n, L, N_KV_HEADS, HEAD_DIM)
    if k_buf is None:
        w_buf = min(WINDOW, PAST_LEN)
        o = prompt_window_attention(q, k, v, rel_bias, sinks)
        new_k, new_v = k[:, L - w_buf:], v[:, L - w_buf:]
    else:
        o, new_k, new_v = sample_window_attention(q, k, v, k_buf, v_buf, rel_bias, sinks)
    b_out = o @ w_attn_br
    g_a, g_b = jnp.split(jax.nn.sigmoid(gates), 2, axis=-1)
    x = x + (g_a * a_out + g_b * b_out) @ w_out
    h2 = rmsnorm(x, norm_ffn)
    f_gate, f_up = jnp.split(h2 @ w_ffn_in, 2, axis=-1)
    x = x + (jax.nn.silu(f_gate) * f_up) @ w_ffn_out
    return x, st_re.astype(x.dtype), st_im.astype(x.dtype), new_k, new_v


def setup_inputs(seed: int = 0) -> dict:
    key = jax.random.key(seed)
    ks = iter(jax.random.split(key, 32))
    f32 = jnp.float32
    nrm = lambda shape, scale: jax.random.normal(next(ks), shape, f32) * scale
    w_buf = min(WINDOW, PAST_LEN)
    lam_im_base = jnp.pi * jnp.arange(STATE_DIM, dtype=f32)
    return {
        'x_prompt': nrm((BATCH, SEQ, D_MODEL), 1.0),
        'x_sample': nrm((DEC_BATCH, DEC_SEQ, D_MODEL), 1.0),
        'state_ssm_re': nrm((DEPTH, DEC_BATCH, N_GROUPS, STATE_DIM), 0.5),
        'state_ssm_im': nrm((DEPTH, DEC_BATCH, N_GROUPS, STATE_DIM), 0.5),
        'cache_win_k': nrm((DEPTH, DEC_BATCH, w_buf, N_KV_HEADS, HEAD_DIM), 1.0),
        'cache_win_v': nrm((DEPTH, DEC_BATCH, w_buf, N_KV_HEADS, HEAD_DIM), 1.0),
        'rel_bias': nrm((NUM_BUCKETS, N_HEADS), 0.2),
        'norm_attn': 1.0 + nrm((DEPTH, D_MODEL), 0.02),
        'w_in': nrm((DEPTH, D_MODEL, IN_COLS), D_MODEL ** -0.5),
        'lam_re': -0.5 * (1.0 + 0.1 * jax.random.uniform(next(ks), (DEPTH, N_GROUPS, STATE_DIM), f32)),
        'lam_im': lam_im_base + nrm((DEPTH, N_GROUPS, STATE_DIM), 0.01),
        'log_dt': jax.random.uniform(next(ks), (DEPTH, N_GROUPS), f32, math.log(1e-3), math.log(1e-1)),
        'b_re': nrm((DEPTH, N_GROUPS, STATE_DIM, GROUP_CH), (2 * GROUP_CH) ** -0.5),
        'b_im': nrm((DEPTH, N_GROUPS, STATE_DIM, GROUP_CH), (2 * GROUP_CH) ** -0.5),
        'c_re': nrm((DEPTH, N_GROUPS, GROUP_CH, STATE_DIM), STATE_DIM ** -0.5),
        'c_im': nrm((DEPTH, N_GROUPS, GROUP_CH, STATE_DIM), STATE_DIM ** -0.5),
        'd_skip': nrm((DEPTH, SSM_WIDTH), 1.0),
        'w_glu_val': nrm((DEPTH, SSM_WIDTH, D_MODEL), SSM_WIDTH ** -0.5),
        'w_glu_gate': nrm((DEPTH, SSM_WIDTH, D_MODEL), SSM_WIDTH ** -0.5),
        'w_attn_br': nrm((DEPTH, ATTN_WIDTH, D_MODEL), ATTN_WIDTH ** -0.5),
        'sinks': nrm((DEPTH, N_HEADS), 0.5),
        'w_out': nrm((DEPTH, D_MODEL, D_MODEL), D_MODEL ** -0.5),
        'norm_ffn': 1.0 + nrm((DEPTH, D_MODEL), 0.02),
        'w_ffn_in': nrm((DEPTH, D_MODEL, 2 * FFN_HIDDEN), D_MODEL ** -0.5),
        'w_ffn_out': nrm((DEPTH, FFN_HIDDEN, D_MODEL), FFN_HIDDEN ** -0.5),
        'norm_final': 1.0 + nrm((D_MODEL,), 0.02),
    }


def reference(x_prompt, x_sample, state_ssm_re, state_ssm_im, cache_win_k, cache_win_v, rel_bias,
              norm_attn, w_in, lam_re, lam_im, log_dt, b_re, b_im, c_re, c_im, d_skip,
              w_glu_val, w_glu_gate, w_attn_br, sinks, w_out, norm_ffn, w_ffn_in, w_ffn_out,
              norm_final):
    xp, xs = x_prompt, x_sample
    p_re, p_im, p_k, p_v = [], [], [], []
    s_re, s_im, s_k, s_v = [], [], [], []
    for l in range(DEPTH):
        lw = (norm_attn[l], w_in[l], lam_re[l], lam_im[l], log_dt[l], b_re[l], b_im[l],
              c_re[l], c_im[l], d_skip[l], w_glu_val[l], w_glu_gate[l], w_attn_br[l],
              sinks[l], w_out[l], norm_ffn[l], w_ffn_in[l], w_ffn_out[l])
        xp, hr, hi, nk, nv = decoder_layer(xp, None, None, None, None, rel_bias, *lw)
        p_re.append(hr); p_im.append(hi); p_k.append(nk); p_v.append(nv)
        xs, hr, hi, nk, nv = decoder_layer(xs, state_ssm_re[l], state_ssm_im[l],
                                           cache_win_k[l], cache_win_v[l], rel_bias, *lw)
        s_re.append(hr); s_im.append(hi); s_k.append(nk); s_v.append(nv)
    y_prompt = rmsnorm(xp, norm_final)
    y_sample = rmsnorm(xs, norm_final)
    return (y_prompt, y_sample,
            jnp.stack(p_re), jnp.stack(p_im), jnp.stack(p_k), jnp.stack(p_v),
            jnp.stack(s_re), jnp.stack(s_im), jnp.stack(s_k), jnp.stack(s_v))
```

```cpp
#include <hip/hip_runtime.h>
#include <cstdio>
#include <cstdint>

constexpr int MP = 8192, MS = 512, M = MP + MS;
constexpr int D = 2048, SW = 1024, KVW = 256, NIN = 6656, FF = 5632;
constexpr int SEQ = 4096, NGRP = 64, NSTATE = 64, GCH = 16, NH = 16, HD = 64, NKV = 4, WIN = 128, DECB = 128, DECS = 4;
constexpr float EPS = 1e-6f;
constexpr size_t O_Y = 0, O_PRE = (size_t)M * D, O_PIM = O_PRE + 8192, O_PK = O_PIM + 8192, O_PV = O_PK + 65536, O_SRE = O_PV + 65536,
                 O_SIM = O_SRE + 524288, O_SK = O_SIM + 524288, O_SV = O_SK + 4194304, O_END = O_SV + 4194304;

namespace pg8 {
#define PG8_LAS __attribute__((address_space(3)))
typedef unsigned short bf16_t;
typedef short bf16x8 __attribute__((ext_vector_type(8)));
typedef float f32x4 __attribute__((ext_vector_type(4)));
typedef unsigned u32x4 __attribute__((ext_vector_type(4)));
constexpr int BM = 256, BK = 64, HALF = 128, HTB = HALF * BK * 2  , STAGE_BYTES = 8 * HTB, NXCD = 8, WGM = 8;

__host__ __device__ __forceinline__ int lds_byte(int r, int c) { const int st = (r >> 4) * 2 + (c >> 5), rr = r & 15, cc = c & 31, ob = rr * 64 + cc * 2; return st * 1024 + (ob ^ (((ob >> 9) & 1) << 5)); }
__host__ __device__ __forceinline__ void stage_rc(int b, int& R, int& C) { const int st = b / 1024, sb = b % 1024, swz = sb ^ (((sb >> 9) & 1) << 5); R = (st >> 1) * 16 + swz / 64; C = (st & 1) * 32 + (swz % 64) / 2; }
__host__ __device__ __forceinline__ int perm32(int rho) { const int n = rho >> 4, i = rho & 15; return 8 * (i >> 2) + 4 * n + (i & 3); }

struct Unit { int pm, pn, pa, pb, kind, kt0, nk, part, slab; };
struct Gemm { const bf16_t* A; const bf16_t* Bt; int K; };

__host__ __device__ __forceinline__ void map_tile(int wgid, int nM, int nN, int& pm, int& pn) {
    const int nwg = nM * nN;
    { const int q = nwg / NXCD, r = nwg % NXCD, xcd = wgid % NXCD, off = wgid / NXCD; wgid = (xcd < r ? xcd * (q + 1) : r * (q + 1) + (xcd - r) * q) + off; }
    const int nig = WGM * nN, gid = wgid / nig, fm = gid * WGM, gsz = (nM - fm) < WGM ? (nM - fm) : WGM;
    pm = fm + ((wgid % nig) % gsz); pn = (wgid % nig) / gsz;
}
struct TailPlan {
    int G, c, R, r, s, tu, tp;
    __host__ __device__ __forceinline__ void init(int nwg, int npairs, int G_, int c_, int smax) {
        G = G_; c = c_; R = nwg / G; r = nwg % G; s = 1; tu = -1; tp = 0;
        if (r > 0) { while (2 * s <= smax && 2 * s * r <= G && 2 * s <= npairs) s *= 2; }
        if (r > 0 && s == 1) { R += 1; r = 0; }
        if (r > 0) { int t, p; if (G % 8 == 0) { const int x = c % 8, y = c / 8; t = (y / s) * 8 + x; p = y % s; } else { t = c / s; p = c % s; }
            if (t < r) { tu = t; tp = p; } }
    }
    __device__ __forceinline__ void uni() { G = __builtin_amdgcn_readfirstlane(G); c = __builtin_amdgcn_readfirstlane(c); R = __builtin_amdgcn_readfirstlane(R); r = __builtin_amdgcn_readfirstlane(r);
        s = __builtin_amdgcn_readfirstlane(s); tu = __builtin_amdgcn_readfirstlane(tu); tp = __builtin_amdgcn_readfirstlane(tp); }
    __host__ __device__ __forceinline__ void krange(int nt, int& kt0, int& nk) const { const int pairs = nt / 2, k0 = tp * pairs / s, k1 = (tp + 1) * pairs / s; kt0 = 2 * k0; nk = 2 * (k1 - k0); }
};
struct StaticOrder {
    static constexpr bool TRIPLE = false;
    int nM, nN, nwg, nt; TailPlan T;
    __host__ __device__ __forceinline__ void init(int M_, int N_, int K_, int G_, int c_, int smax) { nM = M_ / BM; nN = N_ / BM; nwg = nM * nN; nt = K_ / BK; T.init(nwg, nt / 2, G_, c_, smax);
#if defined(__HIP_DEVICE_COMPILE__)
        T.uni();
#endif
    }
    bool tfirst = false;
    __host__ __device__ __forceinline__ bool next(int i, Unit& u) const {
        u.kind = i;
        if (tfirst) { const int np = T.tu >= 0 ? 1 : 0;
            if (i < np) { map_tile(T.R * T.G + T.tu, nM, nN, u.pm, u.pn); u.pa = u.pm; u.pb = u.pn; T.krange(nt, u.kt0, u.nk); u.part = T.tp; u.slab = T.tu * T.s + T.tp; return true; }
            const int j = i - np; if (j >= T.R) return false;
            const long L = (long)j * T.G + T.c; if (L >= nwg) return false; map_tile((int)L, nM, nN, u.pm, u.pn); u.pa = u.pm; u.pb = u.pn; u.kt0 = 0; u.nk = nt; u.part = -1; u.slab = 0; return true; }
        if (i < T.R) { const long L = (long)i * T.G + T.c; if (L >= nwg) return false; map_tile((int)L, nM, nN, u.pm, u.pn); u.pa = u.pm; u.pb = u.pn; u.kt0 = 0; u.nk = nt; u.part = -1; u.slab = 0; return true; }
        if (i == T.R && T.tu >= 0) { map_tile(T.R * T.G + T.tu, nM, nN, u.pm, u.pn); u.pa = u.pm; u.pb = u.pn; T.krange(nt, u.kt0, u.nk); u.part = T.tp; u.slab = T.tu * T.s + T.tp; return true; }
        return false;
    }
    __host__ __device__ __forceinline__ int nfix() const { return T.tu >= 0 ? 1 : 0; }
    __host__ __device__ __forceinline__ void fix(int f, Unit& u) const { (void)next(tfirst ? f : T.R + f, u); }
};
struct TripleOrder {
    static constexpr bool TRIPLE = true;
    int nM, nN, nwg, nt; TailPlan T;
    int mode3, tk, tq;
    __host__ __device__ __forceinline__ void init(int M_, int N_, int K_, int G_, int c_, int smax) { nM = M_ / BM; nN = N_ / BM; nwg = nM * nN; nt = K_ / BK; T.init(nwg, nt / 2, G_, c_, smax);
        mode3 = 0; tk = 0; tq = 0;
        if (T.r > 0 && G_ % 8 == 0 && T.r % 8 == 0 && (T.r / 8) * 12 <= G_ / 8 && nt % 8 == 0) {
            mode3 = 1; const int x = c_ % 8, y = c_ / 8, tl = y / 12, p = y % 12;
            if (tl < T.r / 8) { T.tu = tl * 8 + x; T.tp = p; tk = p >> 2; tq = p & 3; } else { T.tu = -1; T.tp = 0; } }
#if defined(__HIP_DEVICE_COMPILE__)
        T.uni(); mode3 = __builtin_amdgcn_readfirstlane(mode3); tk = __builtin_amdgcn_readfirstlane(tk); tq = __builtin_amdgcn_readfirstlane(tq);
#endif
    }
    __host__ __device__ __forceinline__ void fill(Unit& u, int sk) const { u.kind = sk; u.pa = (sk == 2) ? u.pm + nM : u.pm; u.pb = (sk == 2) ? 2 * nN + u.pn : 2 * u.pn + sk; }
    __host__ __device__ __forceinline__ bool next(int i, Unit& u) const {
        const int tr = i / 3, sk = i - 3 * tr;
        if (tr < T.R) { const long L = (long)tr * T.G + T.c; if (L >= nwg) return false; map_tile((int)L, nM, nN, u.pm, u.pn); fill(u, sk); u.kt0 = 0; u.nk = nt; u.part = -1; u.slab = 0; return true; }
        if (mode3) { if (i == 3 * T.R && T.tu >= 0) { map_tile(T.R * T.G + T.tu, nM, nN, u.pm, u.pn); fill(u, tk); u.kt0 = tq * (nt / 4); u.nk = nt / 4; u.part = tq; u.slab = (T.tu * 3 + tk) * 4 + tq; return true; }
            return false; }
        if (tr == T.R && T.tu >= 0) { map_tile(T.R * T.G + T.tu, nM, nN, u.pm, u.pn); fill(u, sk); T.krange(nt, u.kt0, u.nk); u.part = T.tp; u.slab = (T.tu * 3 + sk) * T.s + T.tp; return true; }
        return false;
    }
    __host__ __device__ __forceinline__ int nfix() const { return (mode3 == 0 && T.tu >= 0) ? 3 : 0; }
    __host__ __device__ __forceinline__ void fix(int f, Unit& u) const { (void)next(3 * T.R + f, u); }
};
struct TailFix { unsigned char* slabs; unsigned* cnt; };
__device__ __forceinline__ void uniformize(Unit& u) {
    u.pm = __builtin_amdgcn_readfirstlane(u.pm); u.pn = __builtin_amdgcn_readfirstlane(u.pn); u.pa = __builtin_amdgcn_readfirstlane(u.pa); u.pb = __builtin_amdgcn_readfirstlane(u.pb);
    u.kind = __builtin_amdgcn_readfirstlane(u.kind); u.kt0 = __builtin_amdgcn_readfirstlane(u.kt0); u.nk = __builtin_amdgcn_readfirstlane(u.nk);
    u.part = __builtin_amdgcn_readfirstlane(u.part); u.slab = __builtin_amdgcn_readfirstlane(u.slab);
}

typedef float f32x2_t __attribute__((ext_vector_type(2))); typedef __bf16 bf16x2_t __attribute__((ext_vector_type(2)));
__device__ __forceinline__ unsigned cvt_pk_bf16(float lo, float hi) { const f32x2_t v = {lo, hi}; const bf16x2_t b = __builtin_convertvector(v, bf16x2_t); return __builtin_bit_cast(unsigned, b); }
__device__ __forceinline__ u32x4 pack8(const f32x4 a, const f32x4 b) { u32x4 w; w.x = cvt_pk_bf16(a[0], a[1]); w.y = cvt_pk_bf16(a[2], a[3]); w.z = cvt_pk_bf16(b[0], b[1]); w.w = cvt_pk_bf16(b[2], b[3]); return w; }
__device__ __forceinline__ void unpack8(const u32x4 w, f32x4& a, f32x4& b) {
    a[0] = __uint_as_float(w.x << 16); a[1] = __uint_as_float(w.x & 0xffff0000u); a[2] = __uint_as_float(w.y << 16); a[3] = __uint_as_float(w.y & 0xffff0000u);
    b[0] = __uint_as_float(w.z << 16); b[1] = __uint_as_float(w.z & 0xffff0000u); b[2] = __uint_as_float(w.w << 16); b[3] = __uint_as_float(w.w & 0xffff0000u); }
__device__ __forceinline__ float sigmoidf_(float x) { return __builtin_amdgcn_rcpf(1.0f + __builtin_amdgcn_exp2f(-1.4426950408889634f * x)); }
__device__ __forceinline__ f32x4 sigmoid4(const f32x4 x) { f32x4 r; r[0] = sigmoidf_(x[0]); r[1] = sigmoidf_(x[1]); r[2] = sigmoidf_(x[2]); r[3] = sigmoidf_(x[3]); return r; }
__device__ __forceinline__ float sumsq4(const f32x4 x) { return (x[0] * x[0] + x[1] * x[1]) + (x[2] * x[2] + x[3] * x[3]); }

struct EpiIn {
    static constexpr bool PERM = true, FINAL = false;
    const PG8_LAS float* rs1;   bf16_t* U; bf16_t* Q; float* KF; float* VF; bf16_t* GT; bf16_t* KB; bf16_t* VT;
    __device__ __forceinline__ void operator()(const f32x4 (&acc)[2][2][4][2], const Unit& u, int wr, int wc, int fr, int fq, unsigned rg) const {
        const int row0 = u.pm * BM + wr * 64 + fr, cl = wc * 32 + 8 * fq, pn = u.pn;
#pragma unroll
        for (int ai = 0; ai < 2; ++ai)
#pragma unroll
            for (int m = 0; m < 4; ++m) { if (!((rg >> (ai * 4 + m)) & 1u)) continue; const int row = row0 + ai * HALF + m * 16; const float s = rs1[u.kind * BM + wr * 64 + ai * HALF + m * 16 + fr];
#pragma unroll
                for (int bj = 0; bj < 2; ++bj) { const int cb = bj * HALF + cl; f32x4 v0 = acc[ai][bj][m][0] * s, v1 = acc[ai][bj][m][1] * s;
                    if (pn < 4) { *(u32x4*)(U + (size_t)row * SW + pn * 256 + cb) = pack8(v0, v1); }
                    else if (pn < 8) { v0 = v0 * 0.125f; v1 = v1 * 0.125f; *(u32x4*)(Q + (size_t)row * SW + (pn - 4) * 256 + cb) = pack8(v0, v1); }
                    else if (pn == 8) { if (row >= MP || (row & (SEQ - 1)) >= SEQ - 128) { float* p = KF + (size_t)row * KVW + cb; *(f32x4*)p = v0; *(f32x4*)(p + 4) = v1; }
                        if (row < MP) { const int kvh = cb >> 6, dd = cb & 63, t = row & (SEQ - 1);
                            *(u32x4*)(KB + ((size_t)(((row >> 12) * 4 + kvh) * (SEQ / 32) + (t >> 5))) * 2048 + (dd >> 4) * 512 + ((((dd >> 3) & 1) * 32 + (t & 31)) * 8)) = pack8(v0, v1); } }
                    else if (pn == 9) { if (row >= MP || (row & (SEQ - 1)) >= SEQ - 128) { float* p = VF + (size_t)row * KVW + cb; *(f32x4*)p = v0; *(f32x4*)(p + 4) = v1; }
                        if (row < MP) { const int kvh = cb >> 6, d0 = cb & 63, t = row & (SEQ - 1), kk = t & 31, r16 = kk & 15;
                            bf16_t* vt = VT + ((size_t)(((row >> 12) * 4 + kvh) * (SEQ / 32) + (t >> 5))) * 2048 + ((kk >> 4) * 2 + (d0 >> 5)) * 512 + ((((r16 >> 2) & 1) * 32 + (d0 & 31)) * 8) + 4 * (r16 >> 3) + (r16 & 3);
                            const u32x4 w = pack8(v0, v1);
                            vt[0] = (bf16_t)(w.x & 0xffffu); vt[8] = (bf16_t)(w.x >> 16); vt[16] = (bf16_t)(w.y & 0xffffu); vt[24] = (bf16_t)(w.y >> 16);
                            vt[32] = (bf16_t)(w.z & 0xffffu); vt[40] = (bf16_t)(w.z >> 16); vt[48] = (bf16_t)(w.w & 0xffffu); vt[56] = (bf16_t)(w.w >> 16); } }
                    else { v0 = sigmoid4(v0); v1 = sigmoid4(v1); *(u32x4*)(GT + (size_t)row * (2 * D) + (pn - 10) * 256 + cb) = pack8(v0, v1); } } }
    }
};
struct EpiMix {
    static constexpr bool PERM = true, FINAL = false;
    const bf16_t* GT; bf16_t* T; bf16_t* MB;
    __device__ __forceinline__ void operator()(const f32x4 (&acc)[2][2][4][2], const Unit& u, int wr, int wc, int fr, int fq, unsigned rg) const {
        const int row0 = u.pm * BM + wr * 64 + fr, cl = wc * 32 + 8 * fq;
        if (u.kind < 2) {
            const int c = (2 * u.pn + u.kind) * HALF + cl;
#pragma unroll
            for (int ai = 0; ai < 2; ++ai)
#pragma unroll
                for (int m = 0; m < 4; ++m) { if (!((rg >> (ai * 4 + m)) & 1u)) continue; const int row = row0 + ai * HALF + m * 16;
                    f32x4 g0, g1; unpack8(*(const u32x4*)(GT + (size_t)row * (2 * D) + c), g0, g1);
                    const f32x4 t0 = g0 * acc[ai][0][m][0] * sigmoid4(acc[ai][1][m][0]), t1 = g1 * acc[ai][0][m][1] * sigmoid4(acc[ai][1][m][1]);
                    *(u32x4*)(T + (size_t)row * D + c) = pack8(t0, t1); }
        } else {
#pragma unroll
            for (int ai = 0; ai < 2; ++ai)
#pragma unroll
                for (int m = 0; m < 4; ++m) { if (!((rg >> (ai * 4 + m)) & 1u)) continue; const int row = row0 + ai * HALF + m * 16;
#pragma unroll
                    for (int bj = 0; bj < 2; ++bj) { const int c = u.pn * BM + bj * HALF + cl;
                        f32x4 g0, g1; unpack8(*(const u32x4*)(GT + (size_t)row * (2 * D) + D + c), g0, g1);
                        f32x4 t0, t1; unpack8(*(const u32x4*)(T + (size_t)row * D + c), t0, t1);
                        *(u32x4*)(MB + (size_t)row * D + c) = pack8(t0 + g0 * acc[ai][bj][m][0], t1 + g1 * acc[ai][bj][m][1]); } }
        }
    }
    __device__ __forceinline__ void fix3(const f32x4 (&vg)[2][2], const f32x4 (&wg)[2][2], const f32x4 (&br)[2][2], int pm, int pn, int wr, int wc, int fr, int fq, int ai, int m) const {
        const int row = pm * BM + wr * 64 + fr + ai * HALF + m * 16, cl = wc * 32 + 8 * fq;
#pragma unroll
        for (int bj = 0; bj < 2; ++bj) { const int c = pn * BM + bj * HALF + cl;
            f32x4 ga0, ga1, gb0, gb1; unpack8(*(const u32x4*)(GT + (size_t)row * (2 * D) + c), ga0, ga1); unpack8(*(const u32x4*)(GT + (size_t)row * (2 * D) + D + c), gb0, gb1);
            const f32x4 (&q)[2][2] = bj == 0 ? vg : wg;
            const f32x4 t0 = ga0 * q[0][0] * sigmoid4(q[1][0]), t1 = ga1 * q[0][1] * sigmoid4(q[1][1]);
            *(u32x4*)(MB + (size_t)row * D + c) = pack8(t0 + gb0 * br[bj][0], t1 + gb1 * br[bj][1]); }
    }
};
struct EpiRes {
    static constexpr bool PERM = true, FINAL = false;
    const float* xp; const float* xs; const bf16_t* rb; float* out; bf16_t* XB; float* RSS;
    __device__ __forceinline__ void operator()(const f32x4 (&acc)[2][2][4][2], const Unit& u, int wr, int wc, int fr, int fq, unsigned rg) const {
        const int row0 = u.pm * BM + wr * 64 + fr, cl = wc * 32 + 8 * fq;
        const float* rbase = (u.pm * BM < MP) ? xp : xs - (size_t)MP * D;
#pragma unroll
        for (int ai = 0; ai < 2; ++ai)
#pragma unroll
            for (int m = 0; m < 4; ++m) { if (!((rg >> (ai * 4 + m)) & 1u)) continue; const int row = row0 + ai * HALF + m * 16; float ss = 0.f;
#pragma unroll
                for (int bj = 0; bj < 2; ++bj) { const size_t off = (size_t)row * D + u.pn * BM + bj * HALF + cl;
                    f32x4 r0, r1; if (rb) unpack8(*(const u32x4*)(rb + off), r0, r1); else { r0 = *(const f32x4*)(rbase + off); r1 = *(const f32x4*)(rbase + off + 4); }
                    const f32x4 v0 = r0 + acc[ai][bj][m][0], v1 = r1 + acc[ai][bj][m][1];
                    ss += sumsq4(v0) + sumsq4(v1);
                    if (out) { *(f32x4*)(out + off) = v0; *(f32x4*)(out + off + 4) = v1; }
                    if (XB) *(u32x4*)(XB + off) = pack8(v0, v1); }
                ss += __shfl_xor(ss, 16); ss += __shfl_xor(ss, 32);
                if (fq == 0) RSS[((size_t)u.pn * M + row) * 4 + wc] = ss; }
    }
};
struct EpiFfn {
    static constexpr bool PERM = true, FINAL = false;
    const PG8_LAS float* RS; bf16_t* ACT;
    __device__ __forceinline__ void operator()(const f32x4 (&acc)[2][2][4][2], const Unit& u, int wr, int wc, int fr, int fq, unsigned rg) const {
        const int row0 = u.pm * BM + wr * 64 + fr, cl = wc * 32 + 8 * fq;
#pragma unroll
        for (int ai = 0; ai < 2; ++ai)
#pragma unroll
            for (int m = 0; m < 4; ++m) { if (!((rg >> (ai * 4 + m)) & 1u)) continue; const int row = row0 + ai * HALF + m * 16;
                const float s = RS[u.kind * BM + wr * 64 + ai * HALF + m * 16 + fr];
                const f32x4 g0 = acc[ai][0][m][0] * s, g1 = acc[ai][0][m][1] * s, u0 = acc[ai][1][m][0] * s, u1 = acc[ai][1][m][1] * s;
                *(u32x4*)(ACT + (size_t)row * FF + u.pn * HALF + cl) = pack8(g0 * sigmoid4(g0) * u0, g1 * sigmoid4(g1) * u1); }
    }
};
struct EpiFinal {
    static constexpr bool PERM = true, FINAL = true;
    const bf16_t* rb; float* RSS; float* out; const float* gf; PG8_LAS float* rt;
    __device__ __forceinline__ void pre_rg(f32x4& a00, f32x4& a01, f32x4& a10, f32x4& a11, int row, int pn, int cl, int wc, int fq) const {
        const size_t o0 = (size_t)row * D + pn * BM + cl, o1 = o0 + HALF;
        f32x4 r0, r1, r2, r3; unpack8(*(const u32x4*)(rb + o0), r0, r1); unpack8(*(const u32x4*)(rb + o1), r2, r3);
        a00 = a00 + r0; a01 = a01 + r1; a10 = a10 + r2; a11 = a11 + r3;
        float ss = (sumsq4(a00) + sumsq4(a01)) + (sumsq4(a10) + sumsq4(a11));
        ss += __shfl_xor(ss, 16); ss += __shfl_xor(ss, 32);
        if (fq == 0) RSS[((size_t)pn * M + row) * 4 + wc] = ss;
    }
    __device__ __forceinline__ void post_rg(const f32x4& a00, const f32x4& a01, const f32x4& a10, const f32x4& a11, int row, int pn, int cl, float r) const {
        const size_t o0 = (size_t)row * D + pn * BM + cl, o1 = o0 + HALF; const float* g0 = gf + pn * BM + cl; const float* g1 = g0 + HALF;
        *(f32x4*)(out + o0) = a00 * r * *(const f32x4*)g0; *(f32x4*)(out + o0 + 4) = a01 * r * *(const f32x4*)(g0 + 4);
        *(f32x4*)(out + o1) = a10 * r * *(const f32x4*)g1; *(f32x4*)(out + o1 + 4) = a11 * r * *(const f32x4*)(g1 + 4);
    }
};
struct NoSync { __device__ __forceinline__ void operator()() const {} };

template <class Epi, class Sched, bool ALIGN_EPI = false, bool SP2 = false, bool SLAB16 = false, class Sync = NoSync>
__device__ __forceinline__ void gemm_phase(PG8_LAS unsigned char* lds, const Gemm g, const Sched& S, const Epi& E, const TailFix tf, const Sync sync = Sync()) {
    const int tid = threadIdx.x, wid = __builtin_amdgcn_readfirstlane(tid >> 6), lane = tid & 63, wr = wid >> 2, wc = wid & 3, fr = lane & 15, fq = lane >> 4;
    const int K = g.K;
    unsigned voffA[2], voffB[2];
#pragma unroll
    for (int i = 0; i < 2; ++i) { int R, C; stage_rc(tid * 16 + i * 8192, R, C); const int Rb = Epi::PERM ? ((R & ~31) + perm32(R & 31)) : R;
        voffA[i] = (unsigned)(R * K + C) * 2u; voffB[i] = (unsigned)(Rb * K + C) * 2u; }
    const size_t kstep = (size_t)(BK * 2);
    const size_t hstep = (size_t)HALF * K * 2;
    const size_t tstep = 2 * hstep;
    const unsigned ldsw = (unsigned)wid * 1024u;
    const int aoff = lds_byte(wr * 64 + fr, fq * 8), boff = lds_byte(wc * 32 + fr, fq * 8);
#define PG8_SA(b, h) (((b) * 2 + (h)) * HTB)
#define PG8_SB(b, h) ((4 + (b) * 2 + (h)) * HTB)
#define PG8_STAGE(bufoff, gbase, voff) do { _Pragma("unroll") for (int _i = 0; _i < 2; ++_i) \
        __builtin_amdgcn_global_load_lds((const unsigned*)((const char*)(gbase) + (voff)[_i]), (PG8_LAS unsigned*)(lds + (bufoff) + ldsw + _i * 8192), 16, 0, 0); } while (0)
#define PG8_LDA(dst, b, h) do { _Pragma("unroll") for (int m = 0; m < 4; ++m) _Pragma("unroll") for (int k = 0; k < 2; ++k) dst[m][k] = *(const PG8_LAS bf16x8*)(lds + PG8_SA(b, h) + aoff + m * 2048 + k * 1024); } while (0)
#define PG8_LDB(dst, b, h) do { _Pragma("unroll") for (int n = 0; n < 2; ++n) _Pragma("unroll") for (int k = 0; k < 2; ++k) dst[n][k] = *(const PG8_LAS bf16x8*)(lds + PG8_SB(b, h) + boff + n * 2048 + k * 1024); } while (0)
#define PG8_MMA(ai, bj, At, Bt) do { __builtin_amdgcn_s_setprio(1); _Pragma("unroll") for (int m = 0; m < 4; ++m) _Pragma("unroll") for (int n = 0; n < 2; ++n) _Pragma("unroll") for (int k = 0; k < 2; ++k) \
        acc[ai][bj][m][n] = __builtin_amdgcn_mfma_f32_16x16x32_bf16(Bt[n][k], At[m][k], acc[ai][bj][m][n], 0, 0, 0); __builtin_amdgcn_s_setprio(0); } while (0)
#define PG8_WAIT_V(n) asm volatile("s_waitcnt vmcnt(" #n ")" ::: "memory")
#define PG8_WAIT_L(n) asm volatile("s_waitcnt lgkmcnt(" #n ")" ::: "memory")
#define PG8_BAR __builtin_amdgcn_s_barrier()
#define PG8_SCHED __builtin_amdgcn_sched_barrier(0)
    Unit cur, nxt; int ui = 0;
    if (!S.next(0, cur)) return;
    uniformize(cur);
    f32x4 acc[2][2][4][2];
#pragma unroll
    for (int a = 0; a < 2; ++a)
#pragma unroll
        for (int b = 0; b < 2; ++b)
#pragma unroll
            for (int m = 0; m < 4; ++m)
#pragma unroll
                for (int n = 0; n < 2; ++n) acc[a][b][m][n] = (f32x4){0.f, 0.f, 0.f, 0.f};
    bf16x8 At[4][2], B0[2][2], B1[2][2];
    const char* cA = (const char*)g.A + (size_t)cur.pa * tstep + (size_t)cur.kt0 * kstep; const char* cB = (const char*)g.Bt + (size_t)cur.pb * tstep + (size_t)cur.kt0 * kstep;
    if constexpr (SP2) {
        PG8_STAGE(PG8_SB(0, 0), cB, voffB); PG8_STAGE(PG8_SB(0, 1), cB + hstep, voffB); PG8_STAGE(PG8_SA(0, 0), cA, voffA); PG8_STAGE(PG8_SA(0, 1), cA + hstep, voffA);
        if (wr == 1) PG8_BAR;
        PG8_WAIT_V(2); PG8_BAR;
        PG8_STAGE(PG8_SB(1, 0), cB + kstep, voffB); PG8_STAGE(PG8_SA(1, 0), cA + kstep, voffA); PG8_STAGE(PG8_SB(1, 1), cB + hstep + kstep, voffB);
        PG8_WAIT_V(6); PG8_BAR;
    } else {
        PG8_STAGE(PG8_SB(0, 0), cB, voffB); PG8_STAGE(PG8_SA(0, 0), cA, voffA); PG8_STAGE(PG8_SB(0, 1), cB + hstep, voffB); PG8_STAGE(PG8_SA(0, 1), cA + hstep, voffA);
        if (wr == 1) PG8_BAR;
        PG8_WAIT_V(4); PG8_BAR;
        PG8_STAGE(PG8_SB(1, 0), cB + kstep, voffB); PG8_STAGE(PG8_SA(1, 0), cA + kstep, voffA); PG8_STAGE(PG8_SB(1, 1), cB + hstep + kstep, voffB);
        PG8_WAIT_V(6); PG8_BAR;
    }
    for (;;) {
        const bool has_next = S.next(ui + 1, nxt); if (has_next) uniformize(nxt);
        const char* nA = has_next ? (const char*)g.A + (size_t)nxt.pa * tstep + (size_t)nxt.kt0 * kstep : cA; const char* nB = has_next ? (const char*)g.Bt + (size_t)nxt.pb * tstep + (size_t)nxt.kt0 * kstep : cB;
        const int nt = cur.nk;
        for (int t = 0; t < nt; t += 2) {
            const bool last = (t == nt - 2);
            const char* a1 = cA + (size_t)(t + 1) * kstep;
            const char* a2 = last ? nA : cA + (size_t)(t + 2) * kstep; const char* b2 = last ? nB : cB + (size_t)(t + 2) * kstep;
            const char* a3 = a2 + kstep; const char* b3 = b2 + kstep;
            if constexpr (SP2) {
            PG8_LDB(B0, 0, 0); PG8_LDB(B1, 0, 1); PG8_SCHED; PG8_LDA(At, 0, 0); PG8_STAGE(PG8_SA(1, 1), a1 + hstep, voffA);
            PG8_WAIT_V(8); PG8_WAIT_L(0); PG8_BAR; PG8_MMA(0, 0, At, B0); PG8_MMA(0, 1, At, B1); PG8_BAR; PG8_SCHED;
            PG8_LDA(At, 0, 1); PG8_STAGE(PG8_SB(0, 0), b2, voffB); PG8_STAGE(PG8_SB(0, 1), b2 + hstep, voffB); PG8_STAGE(PG8_SA(0, 0), a2, voffA);
            PG8_WAIT_V(8); PG8_WAIT_L(0); PG8_BAR; PG8_MMA(1, 0, At, B0); PG8_MMA(1, 1, At, B1); PG8_BAR; PG8_SCHED;
            PG8_LDB(B0, 1, 0); PG8_LDB(B1, 1, 1); PG8_SCHED; PG8_LDA(At, 1, 0); PG8_STAGE(PG8_SA(0, 1), a2 + hstep, voffA);
            PG8_WAIT_V(8); PG8_WAIT_L(0); PG8_BAR; PG8_MMA(0, 0, At, B0); PG8_MMA(0, 1, At, B1); PG8_BAR; PG8_SCHED;
            PG8_LDA(At, 1, 1); PG8_STAGE(PG8_SB(1, 0), b3, voffB); PG8_STAGE(PG8_SB(1, 1), b3 + hstep, voffB); PG8_STAGE(PG8_SA(1, 0), a3, voffA);
            PG8_WAIT_V(8); PG8_WAIT_L(0); PG8_BAR; PG8_MMA(1, 0, At, B0); PG8_MMA(1, 1, At, B1); PG8_BAR; PG8_SCHED;
            } else {
            PG8_LDB(B0, 0, 0); PG8_SCHED; PG8_LDA(At, 0, 0); PG8_STAGE(PG8_SA(1, 1), a1 + hstep, voffA);
            PG8_WAIT_L(8); PG8_BAR; PG8_WAIT_L(0); PG8_MMA(0, 0, At, B0); PG8_BAR; PG8_SCHED;
            PG8_LDB(B1, 0, 1); PG8_STAGE(PG8_SB(0, 0), b2, voffB);
            PG8_BAR; PG8_WAIT_L(0); PG8_MMA(0, 1, At, B1); PG8_BAR;
            PG8_LDA(At, 0, 1); PG8_STAGE(PG8_SA(0, 0), a2, voffA);
            PG8_BAR; PG8_WAIT_L(0); PG8_MMA(1, 0, At, B0); PG8_BAR; PG8_SCHED;
            PG8_STAGE(PG8_SB(0, 1), b2 + hstep, voffB);
            PG8_WAIT_V(6); PG8_BAR; PG8_MMA(1, 1, At, B1); PG8_BAR;
            PG8_LDB(B0, 1, 0); PG8_SCHED; PG8_LDA(At, 1, 0); PG8_STAGE(PG8_SA(0, 1), a2 + hstep, voffA);
            PG8_WAIT_L(8); PG8_BAR; PG8_WAIT_L(0); PG8_MMA(0, 0, At, B0); PG8_BAR; PG8_SCHED;
            PG8_LDB(B1, 1, 1); PG8_STAGE(PG8_SB(1, 0), b3, voffB);
            PG8_BAR; PG8_WAIT_L(0); PG8_MMA(0, 1, At, B1); PG8_BAR;
            PG8_LDA(At, 1, 1); PG8_STAGE(PG8_SA(1, 0), a3, voffA);
            PG8_BAR; PG8_WAIT_L(0); PG8_MMA(1, 0, At, B0); PG8_BAR; PG8_SCHED;
            PG8_STAGE(PG8_SB(1, 1), b3 + hstep, voffB);
            PG8_WAIT_V(6); PG8_BAR; PG8_MMA(1, 1, At, B1); PG8_BAR;
            }
        }
        if constexpr (ALIGN_EPI) { if (wr == 0) PG8_BAR; }
        int fr_e = fr, fq_e = fq, tid_e = tid; asm volatile("" : "+v"(fr_e), "+v"(fq_e), "+v"(tid_e));
        if (cur.part < 0) { if constexpr (!Epi::FINAL) E(acc, cur, wr, wc, fr_e, fq_e, 0xffu); }
        else {
            const __amdgpu_buffer_rsrc_t srs = __builtin_amdgcn_make_buffer_rsrc((void*)tf.slabs, (short)0, 0x7ffff000, 0x00020000);
            constexpr unsigned SLB = SLAB16 ? 131072u : 262144u;
            unsigned so = (unsigned)cur.slab * SLB + (unsigned)tid_e * 16u;
#pragma unroll
            for (int a = 0; a < 2; ++a)
#pragma unroll
                for (int b = 0; b < 2; ++b)
#pragma unroll
                    for (int m = 0; m < 4; ++m) {
                        if constexpr (SLAB16) { __builtin_amdgcn_raw_buffer_store_b128(pack8(acc[a][b][m][0], acc[a][b][m][1]), srs, so, 0, 16); so += 8192u; asm volatile("" : "+v"(so)); }
                        else {
#pragma unroll
                            for (int n = 0; n < 2; ++n) { __builtin_amdgcn_raw_buffer_store_b128(__builtin_bit_cast(u32x4, acc[a][b][m][n]), srs, so, 0, 16); so += 8192u; asm volatile("" : "+v"(so)); } } }
        }
        if (!has_next) break;
#pragma unroll
        for (int a = 0; a < 2; ++a)
#pragma unroll
            for (int b = 0; b < 2; ++b)
#pragma unroll
                for (int m = 0; m < 4; ++m)
#pragma unroll
                    for (int n = 0; n < 2; ++n) acc[a][b][m][n] = (f32x4){0.f, 0.f, 0.f, 0.f};
        cur = nxt; cA = nA; cB = nB; ++ui;
        if constexpr (ALIGN_EPI) { if (wr == 1) PG8_BAR; }
    }
    PG8_WAIT_V(0);
    if constexpr (!ALIGN_EPI) { if (wr == 0) PG8_BAR; }
    PG8_BAR;
    if constexpr (Epi::FINAL) {
        int fr_f = fr, fq_f = fq, tid_f = tid; asm volatile("" : "+v"(fr_f), "+v"(fq_f), "+v"(tid_f));
        const int cl = wc * 32 + 8 * fq_f, row0 = cur.pm * BM + wr * 64 + fr_f;
#pragma unroll
        for (int ai = 0; ai < 2; ++ai)
#pragma unroll
            for (int m = 0; m < 4; ++m) E.pre_rg(acc[ai][0][m][0], acc[ai][0][m][1], acc[ai][1][m][0], acc[ai][1][m][1], row0 + ai * HALF + m * 16, cur.pn, cl, wc, fq_f);
        f32x4 p00 = {0.f, 0.f, 0.f, 0.f}, p01 = p00, p10 = p00, p11 = p00; Unit fu = cur; int prow = 0; const bool hasfix = S.nfix() > 0;
        if (hasfix) {
            const int sN = S.T.s;
            asm volatile("s_waitcnt vmcnt(0)" ::: "memory"); __syncthreads();
            if (tid == 0) { unsigned* cw = tf.cnt + 64 * S.T.tu; __hip_atomic_fetch_add(cw, 1u, __ATOMIC_RELAXED, __HIP_MEMORY_SCOPE_AGENT); unsigned sp = 0;
                while (__hip_atomic_load(cw, __ATOMIC_RELAXED, __HIP_MEMORY_SCOPE_AGENT) < (unsigned)sN) { __builtin_amdgcn_s_sleep(2); if (++sp > (1u << 22)) break; }
                __builtin_amdgcn_fence(__ATOMIC_ACQUIRE, "agent"); asm volatile("s_waitcnt vmcnt(0)" ::: "memory"); }
            __syncthreads();
            S.fix(0, fu); uniformize(fu);
            const int fai = S.T.tp >> 2, fm = S.T.tp & 3;
            const __amdgpu_buffer_rsrc_t srs = __builtin_amdgcn_make_buffer_rsrc((void*)tf.slabs, (short)0, 0x7ffff000, 0x00020000);
            const unsigned sl0 = (unsigned)(fu.slab - fu.part) * 131072u + (unsigned)tid_f * 16u;
#pragma unroll
            for (int b = 0; b < 2; ++b) { unsigned p = sl0 + (unsigned)((fai * 2 + b) * 4 + fm) * 8192u; asm volatile("" : "+v"(p));
                f32x4 v0, v1; unpack8(__builtin_amdgcn_raw_buffer_load_b128(srs, p, 0, 16), v0, v1);
                { u32x4 wq[7];
#pragma unroll
                  for (int j = 1; j < 8; ++j) { wq[j - 1] = (j < sN) ? __builtin_amdgcn_raw_buffer_load_b128(srs, p + (unsigned)j * 131072u, 0, 16) : (u32x4){0u, 0u, 0u, 0u}; }
#pragma unroll
                  for (int j = 1; j < 8; ++j) { f32x4 w0, w1; unpack8(wq[j - 1], w0, w1); v0 = v0 + w0; v1 = v1 + w1; } }
                if (b == 0) { p00 = v0; p01 = v1; } else { p10 = v0; p11 = v1; } }
            prow = fu.pm * BM + wr * 64 + fr_f + fai * HALF + fm * 16;
            E.pre_rg(p00, p01, p10, p11, prow, fu.pn, cl, wc, fq_f);
        }
        sync();
        {
            const int trow = lane >> 1, th = lane & 1;
            const f32x4* rq = (const f32x4*)E.RSS + (size_t)(4 * th) * M + (cur.pm * BM + wid * 32 + trow);
            f32x4 q0 = rq[0], q1 = rq[M], q2 = rq[2 * (size_t)M], q3 = rq[3 * (size_t)M];
            f32x4 z0 = {0.f, 0.f, 0.f, 0.f}, z1 = z0, z2 = z0, z3 = z0;
            if (hasfix && wid == 0) { const int fai = S.T.tp >> 2, fm = S.T.tp & 3; const int prw = fu.pm * BM + fai * HALF + (trow >> 4) * 64 + fm * 16 + (trow & 15);
                const f32x4* pq = (const f32x4*)E.RSS + (size_t)(4 * th) * M + prw; z0 = pq[0]; z1 = pq[M]; z2 = pq[2 * (size_t)M]; z3 = pq[3 * (size_t)M]; }
            q0 = (q0 + q1) + (q2 + q3); float sm = (q0[0] + q0[1]) + (q0[2] + q0[3]); sm += __shfl_xor(sm, 1);
            if (th == 0) E.rt[wid * 32 + trow] = 1.0f / sqrtf(sm * (1.0f / D) + EPS);
            if (hasfix && wid == 0) { z0 = (z0 + z1) + (z2 + z3); float sp2 = (z0[0] + z0[1]) + (z0[2] + z0[3]); sp2 += __shfl_xor(sp2, 1); if (th == 0) E.rt[256 + trow] = 1.0f / sqrtf(sp2 * (1.0f / D) + EPS); }
            asm volatile("s_waitcnt lgkmcnt(0)" ::: "memory"); __syncthreads();
        }
        {
            const int ccol = (wc * 32 + fq_f * 8) >> 2;
#pragma unroll
            for (int ai = 0; ai < 2; ++ai) {
#pragma unroll
                for (int m = 0; m < 4; ++m) { const int rloc = wr * 64 + m * 16 + fr_f; PG8_LAS unsigned char* rowp = lds + rloc * 1024;
#pragma unroll
                    for (int bj = 0; bj < 2; ++bj)
#pragma unroll
                        for (int n = 0; n < 2; ++n) *(PG8_LAS f32x4*)(rowp + (((bj * 32 + ccol + n) ^ (rloc & 7)) * 16)) = acc[ai][bj][m][n]; }
                asm volatile("s_waitcnt lgkmcnt(0)" ::: "memory"); __syncthreads();
                const f32x4 g4 = *(const f32x4*)(E.gf + cur.pn * BM + 4 * lane);
#pragma unroll 4
                for (int k = 0; k < 16; ++k) { const int rloc = wid * 16 + k; const f32x4 v = *(const PG8_LAS f32x4*)(lds + rloc * 1024 + ((lane ^ (rloc & 7)) * 16));
                    const float r = E.rt[ai * HALF + rloc];
                    *(f32x4*)(E.out + (size_t)(cur.pm * BM + ai * HALF + rloc) * D + cur.pn * BM + 4 * lane) = v * r * g4; }
                asm volatile("s_waitcnt lgkmcnt(0)" ::: "memory"); __syncthreads();
            }
            if (hasfix) {
                const int rloc = wr * 16 + fr_f; PG8_LAS unsigned char* rowp = lds + rloc * 1024;
                *(PG8_LAS f32x4*)(rowp + (((ccol) ^ (rloc & 7)) * 16)) = p00; *(PG8_LAS f32x4*)(rowp + (((ccol + 1) ^ (rloc & 7)) * 16)) = p01;
                *(PG8_LAS f32x4*)(rowp + (((32 + ccol) ^ (rloc & 7)) * 16)) = p10; *(PG8_LAS f32x4*)(rowp + (((32 + ccol + 1) ^ (rloc & 7)) * 16)) = p11;
                asm volatile("s_waitcnt lgkmcnt(0)" ::: "memory"); __syncthreads();
                const f32x4 g4 = *(const f32x4*)(E.gf + fu.pn * BM + 4 * lane); const int fai = S.T.tp >> 2, fm = S.T.tp & 3;
#pragma unroll
                for (int k = 0; k < 4; ++k) { const int rl = wid * 4 + k; const f32x4 v = *(const PG8_LAS f32x4*)(lds + rl * 1024 + ((lane ^ (rl & 7)) * 16));
                    const float r = E.rt[256 + rl]; const int grow = fu.pm * BM + fai * HALF + (rl >> 4) * 64 + fm * 16 + (rl & 15);
                    *(f32x4*)(E.out + (size_t)grow * D + fu.pn * BM + 4 * lane) = v * r * g4; }
            }
        }
    }
    if constexpr (Sched::TRIPLE) if (S.mode3 && S.T.tu >= 0) {
        int fr_f = fr, fq_f = fq, tid_f = tid; asm volatile("" : "+v"(fr_f), "+v"(fq_f), "+v"(tid_f));
        const int rgi = S.T.tp;
        asm volatile("s_waitcnt vmcnt(0)" ::: "memory"); __syncthreads();
        if (tid == 0) {
            unsigned* cw = tf.cnt + 64 * S.T.tu;
            __hip_atomic_fetch_add(cw, 1u, __ATOMIC_RELAXED, __HIP_MEMORY_SCOPE_AGENT);
            if (rgi < 8) { unsigned sp = 0;
                while (__hip_atomic_load(cw, __ATOMIC_RELAXED, __HIP_MEMORY_SCOPE_AGENT) < 12u) { __builtin_amdgcn_s_sleep(2); if (++sp > (1u << 22)) break; }
                __builtin_amdgcn_fence(__ATOMIC_ACQUIRE, "agent"); asm volatile("s_waitcnt vmcnt(0)" ::: "memory"); }
        }
        __syncthreads();
        if (rgi < 8) {
            const int fa = rgi >> 2, fm = rgi & 3;
            const __amdgpu_buffer_rsrc_t srs = __builtin_amdgcn_make_buffer_rsrc((void*)tf.slabs, (short)0, 0x7ffff000, 0x00020000);
            static_assert(SLAB16 || !Sched::TRIPLE, "triple parts keep bf16 slabs");
            u32x4 w[3][2][4];
#pragma unroll
            for (int k = 0; k < 3; ++k)
#pragma unroll
                for (int b = 0; b < 2; ++b)
#pragma unroll
                    for (int q = 0; q < 4; ++q) w[k][b][q] = __builtin_amdgcn_raw_buffer_load_b128(srs, (unsigned)(((S.T.tu * 3 + k) * 4 + q)) * 131072u + (unsigned)((fa * 2 + b) * 4 + fm) * 8192u + (unsigned)tid_f * 16u, 0, 16);
            f32x4 sm[3][2][2];
#pragma unroll
            for (int k = 0; k < 3; ++k)
#pragma unroll
                for (int b = 0; b < 2; ++b) { f32x4 v0, v1; unpack8(w[k][b][0], v0, v1);
#pragma unroll
                    for (int q = 1; q < 4; ++q) { f32x4 x0, x1; unpack8(w[k][b][q], x0, x1); v0 = v0 + x0; v1 = v1 + x1; }
                    sm[k][b][0] = v0; sm[k][b][1] = v1; }
            int pm_, pn_; map_tile(S.T.R * S.T.G + S.T.tu, S.nM, S.nN, pm_, pn_); pm_ = __builtin_amdgcn_readfirstlane(pm_); pn_ = __builtin_amdgcn_readfirstlane(pn_);
            E.fix3(sm[0], sm[1], sm[2], pm_, pn_, wr, wc, fr_f, fq_f, fa, fm);
        }
    }
    if constexpr (!Epi::FINAL) if (S.nfix() > 0) {
        const int sN = S.T.s;
        int fr_f = fr, fq_f = fq, tid_f = tid; asm volatile("" : "+v"(fr_f), "+v"(fq_f), "+v"(tid_f));
        asm volatile("s_waitcnt vmcnt(0)" ::: "memory"); __syncthreads();
        if (tid == 0) {
            unsigned* cw = tf.cnt + 64 * S.T.tu;
            __hip_atomic_fetch_add(cw, 1u, __ATOMIC_RELAXED, __HIP_MEMORY_SCOPE_AGENT);
            unsigned sp = 0;
            while (__hip_atomic_load(cw, __ATOMIC_RELAXED, __HIP_MEMORY_SCOPE_AGENT) < (unsigned)sN) { __builtin_amdgcn_s_sleep(2); if (++sp > (1u << 22)) break; }
            __builtin_amdgcn_fence(__ATOMIC_ACQUIRE, "agent"); asm volatile("s_waitcnt vmcnt(0)" ::: "memory");
        }
        __syncthreads();
        const int per = 8 / sN; const unsigned rg = ((1u << per) - 1u) << (per * S.T.tp);
        for (int f = 0; f < S.nfix(); ++f) {
            Unit fu; S.fix(f, fu); uniformize(fu);
            const __amdgpu_buffer_rsrc_t srs = __builtin_amdgcn_make_buffer_rsrc((void*)tf.slabs, (short)0, 0x7ffff000, 0x00020000);
            constexpr unsigned SLB = SLAB16 ? 131072u : 262144u;
            const unsigned sl0 = (unsigned)(fu.slab - fu.part) * SLB + (unsigned)tid_f * 16u;
#pragma unroll
            for (int a = 0; a < 2; ++a)
#pragma unroll
                for (int m = 0; m < 4; ++m) { if (!((rg >> (a * 4 + m)) & 1u)) continue;
#pragma unroll
                    for (int b = 0; b < 2; ++b) {
                        if constexpr (SLAB16) { unsigned p = sl0 + (unsigned)((a * 2 + b) * 4 + m) * 8192u; asm volatile("" : "+v"(p));
                            f32x4 v0, v1; unpack8(__builtin_amdgcn_raw_buffer_load_b128(srs, p, 0, 16), v0, v1);
                            { u32x4 wq[7];
#pragma unroll
                              for (int j = 1; j < 8; ++j) { wq[j - 1] = (j < sN) ? __builtin_amdgcn_raw_buffer_load_b128(srs, p + (unsigned)j * SLB, 0, 16) : (u32x4){0u, 0u, 0u, 0u}; }
#pragma unroll
                              for (int j = 1; j < 8; ++j) { f32x4 w0, w1; unpack8(wq[j - 1], w0, w1); v0 = v0 + w0; v1 = v1 + w1; } }
                            acc[a][b][m][0] = v0; acc[a][b][m][1] = v1; }
                        else {
#pragma unroll
                            for (int n = 0; n < 2; ++n) { unsigned p = sl0 + (unsigned)(((a * 2 + b) * 4 + m) * 2 + n) * 8192u; asm volatile("" : "+v"(p));
                                f32x4 v = __builtin_bit_cast(f32x4, __builtin_amdgcn_raw_buffer_load_b128(srs, p, 0, 16));
                                for (int j = 1; j < sN; ++j) { p += SLB; v = v + __builtin_bit_cast(f32x4, __builtin_amdgcn_raw_buffer_load_b128(srs, p, 0, 16)); } acc[a][b][m][n] = v; } } } }
            E(acc, fu, wr, wc, fr_f, fq_f, rg);
        }
    }
#undef PG8_SA
#undef PG8_SB
#undef PG8_STAGE
#undef PG8_LDA
#undef PG8_LDB
#undef PG8_MMA
#undef PG8_WAIT_V
#undef PG8_WAIT_L
#undef PG8_BAR
#undef PG8_SCHED
}
}

constexpr size_t MiB = 1u << 20;
constexpr size_t WS_CTL = 0, CTL_ZERO_BYTES = 1 * MiB;
constexpr size_t WS_WIN = 1 * MiB;
constexpr size_t WS_WGB = WS_WIN + (size_t)NIN * D * 2;
constexpr size_t WS_WOUT = WS_WGB + (size_t)6144 * SW * 2;
constexpr size_t WS_WFI = WS_WOUT + (size_t)D * D * 2;
constexpr size_t WS_WFO = WS_WFI + (size_t)2 * FF * D * 2;
constexpr size_t WS_A = WS_WFO + (size_t)D * FF * 2;
constexpr size_t WS_XB = WS_A, WS_U = WS_A + (size_t)M * D * 2, WS_Q = WS_U + (size_t)M * SW * 2, WS_T = WS_A + (size_t)M * D * 2;
constexpr size_t WS_B = WS_A + (size_t)M * D * 4;
constexpr size_t WS_KF = WS_B, WS_VF = WS_KF + (size_t)M * KVW * 4, WS_G = WS_VF + (size_t)M * KVW * 4, WS_O = WS_G + (size_t)M * SW * 2;
constexpr size_t WS_C = WS_O + (size_t)M * SW * 2;
constexpr size_t WS_GT = WS_C, WS_X1B = WS_C;
constexpr size_t WS_D = WS_C + (size_t)M * 2 * D * 2;
constexpr size_t WS_E = WS_D + (size_t)M * D * 2;
constexpr size_t WS_RS1 = WS_E, WS_RSS2 = WS_RS1 + (size_t)M * 4, WS_RSS3 = WS_RSS2 + (size_t)M * 32 * 4, WS_KB = WS_RSS3 + (size_t)M * 32 * 4, WS_VT = WS_KB + (size_t)M * KVW * 2,
                 WS_SSMC = WS_VT + (size_t)2 * KVW * SEQ * 2, WS_HLOC = WS_SSMC + (size_t)64 * 2304 * 4, WS_END = WS_HLOC + (size_t)2 * 64 * 16 * 128 * 4;
constexpr size_t WS_ACT = WS_A;
static_assert((size_t)M * FF * 2 <= WS_C - WS_A, "act overlay");
static_assert(WS_O == WS_G + (size_t)M * SW * 2, "g and o contiguous (A tile select in P3)");
constexpr int CW_BAR = 4096, CW_TAIL = 16384;

constexpr int RING_OFF = 0, RING_BYTES = 131072;
constexpr int LDSCTL_OFF = RING_BYTES, MISC_OFF = LDSCTL_OFF + 320;
constexpr int RS2L_OFF = 131072 + 1024;
constexpr int LDS_BYTES = 147456;
constexpr int NWAVES = 8;

#define GAS __attribute__((address_space(1)))
#define LAS __attribute__((address_space(3)))
typedef unsigned short bf16;
typedef unsigned v4u __attribute__((ext_vector_type(4)));
typedef float f32x4 __attribute__((ext_vector_type(4)));
typedef GAS unsigned gu32;
#define RLX_AGENT __ATOMIC_RELAXED, __HIP_MEMORY_SCOPE_AGENT
#define LDS_WAIT() asm volatile("s_waitcnt lgkmcnt(0)" ::: "memory")
#define VM_WAIT() asm volatile("s_waitcnt vmcnt(0)" ::: "memory")
__device__ __forceinline__ unsigned f2bf(float f) { unsigned u = __builtin_bit_cast(unsigned, f); return (u + 0x7fffu + ((u >> 16) & 1u)) >> 16; }
__device__ __forceinline__ unsigned pk2(float lo, float hi) { return f2bf(lo) | (f2bf(hi) << 16); }
__device__ __forceinline__ float bf2f(unsigned short b) { return __uint_as_float((unsigned)b << 16); }

#define XB_TMO      128
#define XB_XCNT(j)  (256  + 64 * (j))
#define XB_XSUB(j)  (1280 + 64 * (j))
#define XB_XGEN(j)  (2304 + 64 * (j))
#define XB_TOP      3328
#define XB_TOPGEN   3392
#define XCD_BAR_WORDS 3456
#define XB_SPIN_CAP (1u << 22)
__device__ __forceinline__ unsigned xb_ld(unsigned* p)              { return __hip_atomic_load(p, __ATOMIC_RELAXED, __HIP_MEMORY_SCOPE_AGENT); }
__device__ __forceinline__ unsigned xb_add(unsigned* p, unsigned v) { return __hip_atomic_fetch_add(p, v, __ATOMIC_RELAXED, __HIP_MEMORY_SCOPE_AGENT); }
__device__ __forceinline__ unsigned xb_xcc_id() { return (unsigned)__builtin_amdgcn_s_getreg((3 << 11) | 20) & 0xFu; }
#define XB_SPIN(cond, bar) do { unsigned _sp = 0; while (cond) { __builtin_amdgcn_s_sleep(1); \
    if ((++_sp & 255u) == 0u) { if (xb_ld(&(bar)[XB_TMO])) break; if (_sp > XB_SPIN_CAP) { atomicAdd(&(bar)[XB_TMO], 1u); break; } } } } while (0)
struct XcdBarrier { unsigned* bar; unsigned x; volatile LAS unsigned* st; };
__device__ __forceinline__ XcdBarrier xcd_barrier_post(unsigned* bar, volatile LAS unsigned* st) {
    XcdBarrier b; b.bar = bar; b.x = xb_xcc_id(); b.st = st;
    if (threadIdx.x == 0) (void)xb_add(&bar[XB_XCNT(b.x)], 1u);
    return b;
}
__device__ __forceinline__ void xcd_barrier_complete(unsigned* bar, unsigned x, unsigned& nloc, unsigned& nx) {
    const unsigned G = gridDim.x * gridDim.y * gridDim.z;
    unsigned sum, cnt, mine, sp = 0u;
    for (;;) {
        sum = 0u; cnt = 0u; mine = 0u;
#pragma unroll
        for (unsigned j = 0; j < 16; ++j) { const unsigned c = xb_ld(&bar[XB_XCNT(j)]); sum += c; cnt += (c > 0u) ? 1u : 0u; mine = (j == x) ? c : mine; }
        if (sum == G) break;
        __builtin_amdgcn_s_sleep(1);
        if ((++sp & 255u) == 0u) { if (xb_ld(&bar[XB_TMO])) break; if (sp > XB_SPIN_CAP) { atomicAdd(&bar[XB_TMO], 1u); break; } }
    }
    nloc = mine > 0u ? mine : 1u; nx = cnt > 0u ? cnt : 1u;
}
__device__ __forceinline__ void xcd_barrier(const XcdBarrier& b) {
    asm volatile("s_waitcnt vmcnt(0)" ::: "memory");
    __syncthreads();
    if (threadIdx.x == 0) {
        unsigned* bar = b.bar;
        __builtin_amdgcn_s_waitcnt(0);
        unsigned nloc = b.st[0], nx = b.st[1];
        if (nloc == 0u) { xcd_barrier_complete(bar, b.x, nloc, nx); b.st[0] = nloc; b.st[1] = nx; }
        const unsigned old = xb_add(&bar[XB_XSUB(b.x)], 1u);
        const unsigned gen = old / nloc;
        if (old + 1u == (gen + 1u) * nloc) {
            __builtin_amdgcn_fence(__ATOMIC_RELEASE, "agent");
            asm volatile("s_waitcnt vmcnt(0)" ::: "memory");
            const unsigned og = xb_add(&bar[XB_TOP], 1u);
            const unsigned tg = og / nx;
            if (og + 1u == (tg + 1u) * nx) xb_add(&bar[XB_TOPGEN], 1u);
            else XB_SPIN(xb_ld(&bar[XB_TOPGEN]) == tg, bar);
            __builtin_amdgcn_fence(__ATOMIC_ACQUIRE, "agent");
            xb_add(&bar[XB_XGEN(b.x)], 1u);
            asm volatile("s_waitcnt vmcnt(0)" ::: "memory");
        } else {
            XB_SPIN(xb_ld(&bar[XB_XGEN(b.x)]) == gen, bar);
            __builtin_amdgcn_fence(__ATOMIC_ACQUIRE, "agent");
            asm volatile("s_waitcnt vmcnt(0)" ::: "memory");
        }
    }
    __syncthreads();
}

struct GridSync { const XcdBarrier* b; __device__ __forceinline__ void operator()() const { xcd_barrier(*b); } };

struct Args { const float* in[26]; float* out; unsigned char* ws; int ph_lo, ph_hi; };
struct Frame {
    LAS unsigned char* lds; int tid, lane, wave, vcu, G;
};
__device__ __forceinline__ float wave_sum(float v) {
#pragma unroll
    for (int o = 1; o < 64; o <<= 1) v += __shfl_xor(v, o);
    return v;
}
__device__ __forceinline__ float wave_max(float v) {
#pragma unroll
    for (int o = 1; o < 64; o <<= 1) v = fmaxf(v, __shfl_xor(v, o));
    return v;
}

__device__ const unsigned char T5B[128] = {0,1,2,3,4,5,6,7,8,9,10,11,12,13,14,15,16,16,16,17,17,18,18,18,19,19,19,20,20,20,20,21,21,21,21,22,22,22,22,22,23,23,23,23,23,23,24,24,24,24,24,24,25,25,25,25,25,25,25,26,26,26,26,26,26,26,26,27,27,27,27,27,27,27,27,27,27,28,28,28,28,28,28,28,28,28,28,29,29,29,29,29,29,29,29,29,29,29,29,30,30,30,30,30,30,30,30,30,30,30,30,30,30,31,31,31,31,31,31,31,31,31,31,31,31,31,31,31};
__device__ __forceinline__ float gelu_tanh(float x) {
    const float y = 0.7978845608028654f * (x + 0.044715f * x * x * x);
    const float e = __builtin_amdgcn_exp2f(-2.0f * 1.4426950408889634f * fabsf(y));
    const float th = (1.0f - e) * __builtin_amdgcn_rcpf(1.0f + e);
    return 0.5f * x * (1.0f + (y < 0.f ? -th : th));
}
typedef short bf16x8_t __attribute__((ext_vector_type(8)));
typedef float f32x16 __attribute__((ext_vector_type(16)));
typedef unsigned u32x2 __attribute__((ext_vector_type(2)));
constexpr int NSEG = 16, LSEG = SEQ / NSEG;
constexpr int SSMC_STRIDE = 2304;
constexpr int HS_ROWB = 272, HS_BYTES = 32 * HS_ROWB;
constexpr int LDS_HS = 0, LDS_TAB = NWAVES * HS_BYTES, TAB_N = 192;
__device__ __forceinline__ int crow(int r, int hi) { return (r & 3) + 8 * (r >> 2) + 4 * hi; }

__device__ __forceinline__ void ssm_consts_item(const Args& a, int g, int lane) {
    unsigned* tb = (unsigned*)(a.ws + WS_SSMC) + (size_t)g * SSMC_STRIDE;
    const float dt = expf(a.in[11][g]);
    auto disc = [&](int p, float& are, float& aim, float& cre, float& cim) {
        const float lr = fminf(a.in[9][g * 64 + p], -1e-4f), li = a.in[10][g * 64 + p];
        const float mag = expf(lr * dt); are = mag * cosf(li * dt); aim = mag * sinf(li * dt);
        const float den = lr * lr + li * li; cre = ((are - 1.0f) * lr + aim * li) / den; cim = (aim * lr - (are - 1.0f) * li) / den; };
    { float are, aim, cre, cim; disc(lane, are, aim, cre, cim);
      float pr = are, pi = aim;
#pragma unroll
      for (int i = 0; i < 8; ++i) { const float nr = pr * pr - pi * pi, ni = 2.0f * pr * pi; pr = nr; pi = ni; }
      tb[lane] = __float_as_uint(are); tb[64 + lane] = __float_as_uint(aim); tb[128 + lane] = __float_as_uint(pr); tb[192 + lane] = __float_as_uint(pi); }
#pragma unroll
    for (int ph = 0; ph < 2; ++ph) { const int p = 32 * ph + (lane & 31); float are, aim, cre, cim; disc(p, are, aim, cre, cim);
        float bre[8], bim[8];
#pragma unroll
        for (int j = 0; j < 8; ++j) { const int c = 8 * (lane >> 5) + j; const float br = a.in[12][(g * 64 + p) * 16 + c], bi = a.in[13][(g * 64 + p) * 16 + c];
            bre[j] = cre * br - cim * bi; bim[j] = cre * bi + cim * br; }
        unsigned* d0 = tb + 256 + ((0 * 2 + ph) * 64 + lane) * 4; unsigned* d1 = tb + 256 + ((1 * 2 + ph) * 64 + lane) * 4;
#pragma unroll
        for (int j = 0; j < 4; ++j) { d0[j] = pk2(bre[2 * j], bre[2 * j + 1]); d1[j] = pk2(bim[2 * j], bim[2 * j + 1]); } }
#pragma unroll
    for (int ks = 0; ks < 4; ++ks) { const int ch = lane & 15; float cv[8];
#pragma unroll
        for (int j = 0; j < 8; ++j) { const int k = 32 * ks + 8 * (lane >> 4) + j, p = k >> 1; cv[j] = (k & 1) ? -a.in[15][(g * 16 + ch) * 64 + p] : a.in[14][(g * 16 + ch) * 64 + p]; }
        unsigned* d = tb + 256 + 1024 + (ks * 64 + lane) * 4;
#pragma unroll
        for (int j = 0; j < 4; ++j) d[j] = pk2(cv[2 * j], cv[2 * j + 1]); }
}

struct SsmConsts { float are, aim; bf16x8_t BF[4]; };
__device__ __forceinline__ bf16x8_t ssm_load_af(const bf16* U, int row0, int g, int lane) { return *(const bf16x8_t*)(U + (size_t)(row0 + (lane & 31)) * SW + g * 16 + 8 * (lane >> 5)); }
__device__ __forceinline__ void ssm_x_chunk(const bf16x8_t af, const SsmConsts& C, f32x16& xar, f32x16& xbr, f32x16& xai, f32x16& xbi) {
    const f32x16 z = {};
    xar = __builtin_amdgcn_mfma_f32_32x32x16_bf16(af, C.BF[0], z, 0, 0, 0); xbr = __builtin_amdgcn_mfma_f32_32x32x16_bf16(af, C.BF[1], z, 0, 0, 0);
    xai = __builtin_amdgcn_mfma_f32_32x32x16_bf16(af, C.BF[2], z, 0, 0, 0); xbi = __builtin_amdgcn_mfma_f32_32x32x16_bf16(af, C.BF[3], z, 0, 0, 0);
#pragma unroll
    for (int i = 0; i < 16; ++i) {
        auto r = __builtin_amdgcn_permlane32_swap(__float_as_uint(xar[i]), __float_as_uint(xbr[i]), false, false); xar[i] = __uint_as_float(r[0]); xbr[i] = __uint_as_float(r[1]);
        auto q = __builtin_amdgcn_permlane32_swap(__float_as_uint(xai[i]), __float_as_uint(xbi[i]), false, false); xai[i] = __uint_as_float(q[0]); xbi[i] = __uint_as_float(q[1]); }
}
#define SSM_STEP(XR, XI) do { float t1_ = __builtin_fmaf(-C.aim, hi, (XR)), t2_ = __builtin_fmaf(C.aim, hr, (XI)); asm("" : "+v"(t1_)); asm("" : "+v"(t2_)); \
                              float nr_ = __builtin_fmaf(C.are, hr, t1_), ni_ = __builtin_fmaf(C.are, hi, t2_); asm("" : "+v"(nr_)); asm("" : "+v"(ni_)); hr = nr_; hi = ni_; } while (0)
__device__ __forceinline__ void ssm_pass_a(const Args& a, int b, int g, int s, int lane) {
    const bf16* U = (const bf16*)(a.ws + WS_U); const unsigned* tb = (const unsigned*)(a.ws + WS_SSMC) + (size_t)g * SSMC_STRIDE;
    SsmConsts C; C.are = __uint_as_float(tb[lane]); C.aim = __uint_as_float(tb[64 + lane]);
#pragma unroll
    for (int v = 0; v < 4; ++v) C.BF[v] = *(const bf16x8_t*)(tb + 256 + (v * 64 + lane) * 4);
    float hr = 0.f, hi = 0.f;
    bf16x8_t af = ssm_load_af(U, b * SEQ + s * LSEG, g, lane);
    for (int ch = 0; ch < LSEG / 32; ++ch) {
        const bf16x8_t afn = ssm_load_af(U, b * SEQ + s * LSEG + (ch + 1 < LSEG / 32 ? ch + 1 : ch) * 32, g, lane);
        f32x16 xar, xbr, xai, xbi; ssm_x_chunk(af, C, xar, xbr, xai, xbi); af = afn;
#pragma unroll
        for (int j = 0; j < 4; ++j) {
#pragma unroll
            for (int k = 0; k < 4; ++k) SSM_STEP(xar[4 * j + k], xai[4 * j + k]);
#pragma unroll
            for (int k = 0; k < 4; ++k) SSM_STEP(xbr[4 * j + k], xbi[4 * j + k]); }
    }
    float* hl = (float*)(a.ws + WS_HLOC) + ((size_t)(b * 64 + g) * NSEG + s) * 128; hl[lane] = hr; hl[64 + lane] = hi;
}
__device__ __forceinline__ u32x2 ssm_load_uw(const bf16* U, int row0, int tl, int g, int lane) { return *(const GAS u32x2*)(U + (size_t)(row0 + 16 * tl + (lane & 15)) * SW + g * 16 + 4 * (lane >> 4)); }
__device__ __forceinline__ void ssm_y_chunk(const Args& a, int row0, int g, int lane, LAS unsigned char* hs, const bf16x8_t (&CF)[4], const float (&dsk)[4], const u32x2 uw0, const u32x2 uw1) {
    bf16* G = (bf16*)(a.ws + WS_G);
    LDS_WAIT(); asm volatile("" ::: "memory");
#pragma unroll
    for (int tl = 0; tl < 2; ++tl) { f32x4 acc = {0.f, 0.f, 0.f, 0.f};
#pragma unroll
        for (int ks = 0; ks < 4; ++ks) { const bf16x8_t hf = *(const LAS bf16x8_t*)(hs + (16 * tl + (lane & 15)) * HS_ROWB + 64 * ks + 16 * (lane >> 4));
            acc = __builtin_amdgcn_mfma_f32_16x16x32_bf16(CF[ks], hf, acc, 0, 0, 0); }
        const size_t off = (size_t)(row0 + 16 * tl + (lane & 15)) * SW + g * 16 + 4 * (lane >> 4);
        const u32x2 uw = tl == 0 ? uw0 : uw1;
        const float y0 = acc[0] + dsk[0] * __uint_as_float(uw.x << 16), y1 = acc[1] + dsk[1] * __uint_as_float(uw.x & 0xffff0000u);
        const float y2 = acc[2] + dsk[2] * __uint_as_float(uw.y << 16), y3 = acc[3] + dsk[3] * __uint_as_float(uw.y & 0xffff0000u);
        u32x2 o; o.x = pg8::cvt_pk_bf16(gelu_tanh(y0), gelu_tanh(y1)); o.y = pg8::cvt_pk_bf16(gelu_tanh(y2), gelu_tanh(y3));
        *(GAS u32x2*)(G + off) = o; }
    LDS_WAIT(); asm volatile("" ::: "memory");
}
#define SSM_STEP_W(XR, XI, T) do { SSM_STEP(XR, XI); *(LAS unsigned*)(hs + (T) * HS_ROWB + 4 * lane) = pg8::cvt_pk_bf16(hr, hi); } while (0)
__device__ __forceinline__ void ssm_pass_b_prompt(const Args& a, int b, int g, int s, int lane, LAS unsigned char* hs) {
    const bf16* U = (const bf16*)(a.ws + WS_U); const unsigned* tb = (const unsigned*)(a.ws + WS_SSMC) + (size_t)g * SSMC_STRIDE;
    SsmConsts C; C.are = __uint_as_float(tb[lane]); C.aim = __uint_as_float(tb[64 + lane]);
    const float alr = __uint_as_float(tb[128 + lane]), ali = __uint_as_float(tb[192 + lane]);
#pragma unroll
    for (int v = 0; v < 4; ++v) C.BF[v] = *(const bf16x8_t*)(tb + 256 + (v * 64 + lane) * 4);
    bf16x8_t CF[4];
#pragma unroll
    for (int ks = 0; ks < 4; ++ks) CF[ks] = *(const bf16x8_t*)(tb + 256 + 1024 + (ks * 64 + lane) * 4);
    float dsk[4];
#pragma unroll
    for (int r = 0; r < 4; ++r) dsk[r] = a.in[16][g * 16 + 4 * (lane >> 4) + r];
    float hr = 0.f, hi = 0.f;
    const float* hl = (const float*)(a.ws + WS_HLOC) + (size_t)(b * 64 + g) * NSEG * 128;
    { float lre[NSEG - 1], lim[NSEG - 1];
#pragma unroll
      for (int sp = 0; sp < NSEG - 1; ++sp) { const bool on = sp < s; lre[sp] = on ? hl[sp * 128 + lane] : 0.f; lim[sp] = on ? hl[sp * 128 + 64 + lane] : 0.f; }
#pragma unroll
      for (int sp = 0; sp < NSEG - 1; ++sp) if (sp < s) { const float nr = alr * hr - ali * hi + lre[sp], ni = alr * hi + ali * hr + lim[sp]; hr = nr; hi = ni; } }
    bf16x8_t af = ssm_load_af(U, b * SEQ + s * LSEG, g, lane);
    for (int ch = 0; ch < LSEG / 32; ++ch) {
        const int row0 = b * SEQ + s * LSEG + ch * 32;
        const bf16x8_t afn = ssm_load_af(U, row0 + (ch + 1 < LSEG / 32 ? 32 : 0), g, lane);
        const u32x2 uw0 = ssm_load_uw(U, row0, 0, g, lane), uw1 = ssm_load_uw(U, row0, 1, g, lane);
        f32x16 xar, xbr, xai, xbi; ssm_x_chunk(af, C, xar, xbr, xai, xbi); af = afn;
#pragma unroll
        for (int j = 0; j < 4; ++j) {
#pragma unroll
            for (int k = 0; k < 4; ++k) SSM_STEP_W(xar[4 * j + k], xai[4 * j + k], 8 * j + k);
#pragma unroll
            for (int k = 0; k < 4; ++k) SSM_STEP_W(xbr[4 * j + k], xbi[4 * j + k], 8 * j + 4 + k); }
        ssm_y_chunk(a, row0, g, lane, hs, CF, dsk, uw0, uw1);
    }
    if (s == NSEG - 1) { a.out[O_PRE + (size_t)(b * 64 + g) * 64 + lane] = hr; a.out[O_PIM + (size_t)(b * 64 + g) * 64 + lane] = hi; }
}
__device__ __forceinline__ void ssm_sample_item(const Args& a, int n8, int g, int lane, LAS unsigned char* hs) {
    const bf16* U = (const bf16*)(a.ws + WS_U); const unsigned* tb = (const unsigned*)(a.ws + WS_SSMC) + (size_t)g * SSMC_STRIDE;
    SsmConsts C; C.are = __uint_as_float(tb[lane]); C.aim = __uint_as_float(tb[64 + lane]);
#pragma unroll
    for (int v = 0; v < 4; ++v) C.BF[v] = *(const bf16x8_t*)(tb + 256 + (v * 64 + lane) * 4);
    bf16x8_t CF[4];
#pragma unroll
    for (int ks = 0; ks < 4; ++ks) CF[ks] = *(const bf16x8_t*)(tb + 256 + 1024 + (ks * 64 + lane) * 4);
    float dsk[4];
#pragma unroll
    for (int r = 0; r < 4; ++r) dsk[r] = a.in[16][g * 16 + 4 * (lane >> 4) + r];
    const int row0 = MP + n8 * 32;
    const u32x2 uw0 = ssm_load_uw(U, row0, 0, g, lane), uw1 = ssm_load_uw(U, row0, 1, g, lane);
    f32x16 xar, xbr, xai, xbi; ssm_x_chunk(ssm_load_af(U, row0, g, lane), C, xar, xbr, xai, xbi);
    float h0r[8], h0i[8];
#pragma unroll
    for (int q = 0; q < 8; ++q) { const size_t si = (size_t)((n8 * 8 + q) * 64 + g) * 64 + lane; h0r[q] = a.in[2][si]; h0i[q] = a.in[3][si]; }
#pragma unroll
    for (int j = 0; j < 4; ++j) {
        { float hr = h0r[2 * j], hi = h0i[2 * j];
#pragma unroll
          for (int k = 0; k < 4; ++k) SSM_STEP_W(xar[4 * j + k], xai[4 * j + k], 8 * j + k);
          const size_t so = (size_t)((n8 * 8 + 2 * j) * 64 + g) * 64 + lane; a.out[O_SRE + so] = hr; a.out[O_SIM + so] = hi; }
        { float hr = h0r[2 * j + 1], hi = h0i[2 * j + 1];
#pragma unroll
          for (int k = 0; k < 4; ++k) SSM_STEP_W(xbr[4 * j + k], xbi[4 * j + k], 8 * j + 4 + k);
          const size_t so = (size_t)((n8 * 8 + 2 * j + 1) * 64 + g) * 64 + lane; a.out[O_SRE + so] = hr; a.out[O_SIM + so] = hi; }
    }
    ssm_y_chunk(a, row0, g, lane, hs, CF, dsk, uw0, uw1);
}

__device__ __forceinline__ void attn_prompt_item(const Args& a, int b, int h, int qt, int lane, const LAS float* tab) {
    const bf16* Q = (const bf16*)(a.ws + WS_Q); const bf16* KB = (const bf16*)(a.ws + WS_KB); const bf16* VT = (const bf16*)(a.ws + WS_VT); bf16* O = (bf16*)(a.ws + WS_O);
    const int kvh = h >> 2, lq = lane & 31, hh = lane >> 5, t0 = 32 * qt;
    const size_t rowq = (size_t)b * SEQ + t0 + lq;
    bf16x8_t qf[4];
#pragma unroll
    for (int ks = 0; ks < 4; ++ks) qf[ks] = *(const bf16x8_t*)(Q + rowq * SW + h * 64 + 16 * ks + 8 * hh);
    f32x16 S[5]; float mx = -1e30f;
    const LAS float* th = tab + h * TAB_N;
    bf16x8_t kf[5][4];
#pragma unroll
    for (int i = 0; i < 5; ++i) { const int ktile = qt - 4 + i; const int kt0 = 32 * (ktile >= 0 ? ktile : 0);
        const bf16* kp = KB + ((size_t)((b * 4 + kvh) * (SEQ / 32) + (kt0 >> 5))) * 2048 + lane * 8;
#pragma unroll
        for (int ks = 0; ks < 4; ++ks) kf[i][ks] = *(const bf16x8_t*)(kp + 512 * ks); }
#pragma unroll
    for (int i = 0; i < 5; ++i) {
        const int ktile = qt - 4 + i; const bool tv = ktile >= 0; const int kt0 = 32 * (tv ? ktile : 0);
        f32x16 acc = {};
#pragma unroll
        for (int ks = 0; ks < 4; ++ks) acc = __builtin_amdgcn_mfma_f32_32x32x16_bf16(kf[i][ks], qf[ks], acc, 0, 0, 0);
        const int dbase = (t0 - kt0) + lq - 4 * hh + 32;
#pragma unroll
        for (int r = 0; r < 16; ++r) { const float bv = tv ? th[dbase - (r & 3) - 8 * (r >> 2)] : -1e30f; acc[r] += bv; mx = fmaxf(mx, acc[r]); }
        S[i] = acc;
    }
    bf16x8_t vfr[5][2][2];
#pragma unroll
    for (int i = 0; i < 5; ++i) { const int ktile = qt - 4 + i; const int kt0 = 32 * (ktile >= 0 ? ktile : 0);
        const bf16* vp = VT + ((size_t)((b * 4 + kvh) * (SEQ / 32) + (kt0 >> 5))) * 2048 + lane * 8;
#pragma unroll
        for (int s2 = 0; s2 < 2; ++s2)
#pragma unroll
            for (int db = 0; db < 2; ++db) vfr[i][s2][db] = *(const bf16x8_t*)(vp + (s2 * 2 + db) * 512); }
    { auto rr = __builtin_amdgcn_permlane32_swap(__float_as_uint(mx), __float_as_uint(mx), false, false); mx = fmaxf(__uint_as_float(rr[0]), __uint_as_float(rr[1])); }
    const float sink = a.in[20][h]; mx = fmaxf(mx, sink);
    const float L2E = 1.4426950408889634f, mb = -mx * L2E; float sum = 0.f;
#pragma unroll
    for (int i = 0; i < 5; ++i)
#pragma unroll
        for (int r = 0; r < 16; ++r) { const float p = __builtin_amdgcn_exp2f(S[i][r] * L2E + mb); S[i][r] = p; sum += p; }
    { auto rr = __builtin_amdgcn_permlane32_swap(__float_as_uint(sum), __float_as_uint(sum), false, false); sum = __uint_as_float(rr[0]) + __uint_as_float(rr[1]); }
    const float inv = 1.0f / (sum + __builtin_amdgcn_exp2f(sink * L2E + mb));
    f32x16 o0 = {}, o1 = {};
#pragma unroll
    for (int i = 0; i < 5; ++i) {
#pragma unroll
        for (int s2 = 0; s2 < 2; ++s2) {
            pg8::u32x4 pw; pw.x = pg8::cvt_pk_bf16(S[i][8 * s2 + 0], S[i][8 * s2 + 1]); pw.y = pg8::cvt_pk_bf16(S[i][8 * s2 + 2], S[i][8 * s2 + 3]);
            pw.z = pg8::cvt_pk_bf16(S[i][8 * s2 + 4], S[i][8 * s2 + 5]); pw.w = pg8::cvt_pk_bf16(S[i][8 * s2 + 6], S[i][8 * s2 + 7]);
            const bf16x8_t pf = __builtin_bit_cast(bf16x8_t, pw);
#pragma unroll
            for (int db = 0; db < 2; ++db) {
                const bf16x8_t vf = vfr[i][s2][db];
                if (db == 0) o0 = __builtin_amdgcn_mfma_f32_32x32x16_bf16(vf, pf, o0, 0, 0, 0); else o1 = __builtin_amdgcn_mfma_f32_32x32x16_bf16(vf, pf, o1, 0, 0, 0);
            } } }
    bf16* op = O + rowq * SW + h * 64 + 4 * hh;
#pragma unroll
    for (int gq = 0; gq < 4; ++gq) {
        u32x2 w0; w0.x = pg8::cvt_pk_bf16(o0[4 * gq] * inv, o0[4 * gq + 1] * inv); w0.y = pg8::cvt_pk_bf16(o0[4 * gq + 2] * inv, o0[4 * gq + 3] * inv);
        u32x2 w1; w1.x = pg8::cvt_pk_bf16(o1[4 * gq] * inv, o1[4 * gq + 1] * inv); w1.y = pg8::cvt_pk_bf16(o1[4 * gq + 2] * inv, o1[4 * gq + 3] * inv);
        *(GAS u32x2*)(op + 8 * gq) = w0; *(GAS u32x2*)(op + 32 + 8 * gq) = w1; }
}
__device__ __forceinline__ void attn_sample_item(const Args& a, int n, int h, int lane_in, const LAS float* tab, LAS unsigned char* ws_l) {
    int lane = lane_in; asm volatile("" : "+v"(lane));
    const bf16* Q = (const bf16*)(a.ws + WS_Q); const float* KF = (const float*)(a.ws + WS_KF); const float* VF = (const float*)(a.ws + WS_VF); bf16* O = (bf16*)(a.ws + WS_O);
    const int kvh = h >> 2; const size_t row0 = (size_t)MP + n * 4;
    LAS float* ps = (LAS float*)ws_l;
    const LAS float* th = tab + h * TAB_N;
    { const int k4 = lane >> 4, c = lane & 15;
      f32x4 qv[4];
#pragma unroll
      for (int i = 0; i < 4; ++i) { const u32x2 w = *(const GAS u32x2*)(Q + (row0 + i) * SW + h * 64 + 4 * c);
          qv[i] = (f32x4){__uint_as_float(w.x << 16), __uint_as_float(w.x & 0xffff0000u), __uint_as_float(w.y << 16), __uint_as_float(w.y & 0xffff0000u)}; }
#define ROWSUM(x) do { x += __builtin_bit_cast(float, __builtin_amdgcn_mov_dpp(__builtin_bit_cast(int, x), 0x128, 0xf, 0xf, false)); x += __builtin_bit_cast(float, __builtin_amdgcn_mov_dpp(__builtin_bit_cast(int, x), 0x124, 0xf, 0xf, false)); \
                       x += __builtin_bit_cast(float, __builtin_amdgcn_mov_dpp(__builtin_bit_cast(int, x), 0x122, 0xf, 0xf, false)); x += __builtin_bit_cast(float, __builtin_amdgcn_mov_dpp(__builtin_bit_cast(int, x), 0x121, 0xf, 0xf, false)); } while (0)
#pragma unroll
      for (int bt = 0; bt < 3; ++bt) {
          f32x4 kq[11];
#pragma unroll
          for (int u = 0; u < 11; ++u) { const int key = 4 * (bt * 11 + u) + k4;
              const float* kp = (key >= 128) ? KF + (row0 + (key - 128)) * KVW + kvh * 64 : a.in[4] + ((size_t)(n * 128 + key) * 4 + kvh) * 64;
              kq[u] = *(const GAS f32x4*)(kp + 4 * c); }
#pragma unroll
          for (int u = 0; u < 11; ++u) { const int key = 4 * (bt * 11 + u) + k4; const f32x4 kv = kq[u];
              float s0 = qv[0].x * kv.x + qv[0].y * kv.y + qv[0].z * kv.z + qv[0].w * kv.w, s1 = qv[1].x * kv.x + qv[1].y * kv.y + qv[1].z * kv.z + qv[1].w * kv.w;
              float s2 = qv[2].x * kv.x + qv[2].y * kv.y + qv[2].z * kv.z + qv[2].w * kv.w, s3 = qv[3].x * kv.x + qv[3].y * kv.y + qv[3].z * kv.z + qv[3].w * kv.w;
              ROWSUM(s0); ROWSUM(s1); ROWSUM(s2); ROWSUM(s3);
              const int ib = 160 - key;
              if (c == 0) *(LAS f32x4*)(ps + 4 * key) = (f32x4){s0 + th[ib], s1 + th[ib + 1], s2 + th[ib + 2], s3 + th[ib + 3]}; }
          asm volatile("" ::: "memory");
      }
#undef ROWSUM
    }
    LDS_WAIT(); asm volatile("" ::: "memory");
    const f32x4 NEG4 = {-1e30f, -1e30f, -1e30f, -1e30f};
    f32x4 sA = *(const LAS f32x4*)(ps + 4 * lane), sB = *(const LAS f32x4*)(ps + 4 * (64 + lane)), sC = (lane < 4) ? *(const LAS f32x4*)(ps + 4 * (128 + (lane & 3))) : NEG4;
    LDS_WAIT(); asm volatile("" ::: "memory");
    const float sink = a.in[20][h], L2E = 1.4426950408889634f;
    f32x4 inv;
#pragma unroll
    for (int i = 0; i < 4; ++i) {
        const float mx = fmaxf(wave_max(fmaxf(fmaxf(sA[i], sB[i]), sC[i])), sink), mb = -mx * L2E;
        const float e0 = __builtin_amdgcn_exp2f(sA[i] * L2E + mb), e1 = __builtin_amdgcn_exp2f(sB[i] * L2E + mb), e2 = __builtin_amdgcn_exp2f(sC[i] * L2E + mb);
        sA[i] = e0; sB[i] = e1; sC[i] = e2;
        inv[i] = 1.0f / (wave_sum(e0 + e1 + e2) + __builtin_amdgcn_exp2f(sink * L2E + mb));
    }
    *(LAS f32x4*)(ps + 4 * lane) = sA * inv; *(LAS f32x4*)(ps + 4 * (64 + lane)) = sB * inv; if (lane < 8) *(LAS f32x4*)(ps + 4 * (128 + lane)) = sC * inv;
    LDS_WAIT(); asm volatile("" ::: "memory");
    float o0 = 0.f, o1 = 0.f, o2 = 0.f, o3 = 0.f;
    const float* vc = a.in[5] + ((size_t)(n * 128) * 4 + kvh) * 64 + lane;
#pragma unroll 32
    for (int j = 0; j < 128; ++j) { const float v = vc[(size_t)j * 256];   const f32x4 p = *(const LAS f32x4*)(ps + 4 * j); o0 += p.x * v; o1 += p.y * v; o2 += p.z * v; o3 += p.w * v; }
#pragma unroll
    for (int j = 128; j < 132; ++j) { const float v = VF[(row0 + (j - 128)) * KVW + kvh * 64 + lane]; const f32x4 p = *(const LAS f32x4*)(ps + 4 * j); o0 += p.x * v; o1 += p.y * v; o2 += p.z * v; o3 += p.w * v; }
    O[(row0 + 0) * SW + h * 64 + lane] = (bf16)f2bf(o0); O[(row0 + 1) * SW + h * 64 + lane] = (bf16)f2bf(o1);
    O[(row0 + 2) * SW + h * 64 + lane] = (bf16)f2bf(o2); O[(row0 + 3) * SW + h * 64 + lane] = (bf16)f2bf(o3);
    LDS_WAIT(); asm volatile("" ::: "memory");
}
#ifndef DUP_SUB
#define DUP_SUB 0
#endif
__device__ __forceinline__ void p2a_phase(const Frame& F, const Args& a) {
    unsigned char* ws = a.ws;
    const int gw = F.vcu * NWAVES + F.wave, NGW = F.G * NWAVES;
    LAS float* tab = (LAS float*)(F.lds + LDS_TAB);
    for (int i = F.tid; i < NH * TAB_N; i += NWAVES * 64) { const int h = i / TAB_N, dist = i % TAB_N - 32; tab[i] = (dist >= 0 && dist < WIN) ? a.in[6][T5B[dist] * 16 + h] : -1e30f; }
    __syncthreads();
    for (int rp_ = 0; rp_ < (DUP_SUB == 1 ? 2 : 1); ++rp_)
    for (int it = gw; it < 2 * NGRP * (NSEG - 1); it += NGW) { const int bg = it / (NSEG - 1), sgm = it % (NSEG - 1); ssm_pass_a(a, bg / NGRP, bg % NGRP, sgm, F.lane); }
    for (int rp_ = 0; rp_ < (DUP_SUB == 2 ? 2 : 1); ++rp_)
    for (int it = gw; it < 2 * NH * (SEQ / 32); it += NGW) attn_prompt_item(a, it / (NH * (SEQ / 32)), (it / (SEQ / 32)) % NH, it % (SEQ / 32), F.lane, tab);
    { LAS unsigned char* wsl = F.lds + LDS_HS + F.wave * HS_BYTES;
      for (int rp_ = 0; rp_ < (DUP_SUB == 3 ? 2 : 1); ++rp_)
      for (int it = gw; it < DECB * NH; it += NGW) attn_sample_item(a, it / NH, it % NH, F.lane, tab, wsl); }
    const float* KF = (const float*)(ws + WS_KF); const float* VF = (const float*)(ws + WS_VF);
    for (int rp_ = 0; rp_ < (DUP_SUB == 4 ? 2 : 1); ++rp_)
    for (int r0 = gw; r0 < (DECB + 2) * 128 * 2; r0 += 4 * NGW) {
        f32x4 val[4]; float* dst[4];
#pragma unroll
        for (int u = 0; u < 4; ++u) { int rr = r0 + u * NGW; if (rr >= (DECB + 2) * 128 * 2) rr = r0;
            const int kv = rr & 1, row = rr >> 1, n = row >> 7, j = row & 127; const float* src;
            if (n < DECB) { src = (j < 124) ? a.in[4 + kv] + (size_t)(n * 128 + j + 4) * 256 : (kv ? VF : KF) + (size_t)(MP + n * 4 + (j - 124)) * KVW; dst[u] = a.out + (kv ? O_SV : O_SK) + (size_t)row * 256; }
            else { const int b = n - DECB; src = (kv ? VF : KF) + (size_t)(b * SEQ + SEQ - 128 + j) * KVW; dst[u] = a.out + (kv ? O_PV : O_PK) + (size_t)(b * 128 + j) * 256; }
            val[u] = *(const GAS f32x4*)(src + 4 * F.lane); }
#pragma unroll
        for (int u = 0; u < 4; ++u) *(GAS f32x4*)(dst[u] + 4 * F.lane) = val[u];
    }
}
__device__ __forceinline__ void p2b_phase(const Frame& F, const Args& a) {
    const int gw = F.vcu * NWAVES + F.wave, NGW = F.G * NWAVES;
    LAS unsigned char* hs = F.lds + LDS_HS + F.wave * HS_BYTES;
    for (int it = gw; it < 2 * NGRP * NSEG; it += NGW) { const int bg = it / NSEG, sgm = it % NSEG; ssm_pass_b_prompt(a, bg / NGRP, bg % NGRP, sgm, F.lane, hs); }
    for (int it = gw; it < (DECB / 8) * NGRP; it += NGW) ssm_sample_item(a, it / NGRP, it % NGRP, F.lane, hs);
}
struct P0Item { const float* W; const float* ksc; bf16* WT; int K, N, k0, n0, drow0; };
__device__ __forceinline__ void p0_load(const P0Item& d, f32x4 (&v)[16], int lane) {
    const int r = lane >> 4, c = lane & 15;
#pragma unroll
    for (int j = 0; j < 16; ++j) { const int k = d.k0 + 8 * (j >> 1) + 2 * r + (j & 1); v[j] = *(const GAS f32x4*)(d.W + (size_t)k * d.N + d.n0 + 4 * c); }
}
__device__ __forceinline__ void p0_finish(const P0Item& d, f32x4 (&v)[16], LAS unsigned* scr, int lane) {
    const int r = lane >> 4, c = lane & 15;
    if (d.ksc) {
#pragma unroll
        for (int j = 0; j < 16; ++j) v[j] = v[j] * d.ksc[d.k0 + 8 * (j >> 1) + 2 * r + (j & 1)]; }
#pragma unroll
    for (int m = 0; m < 8; ++m)
#pragma unroll
        for (int e = 0; e < 4; ++e) { const int n = 4 * c + e; scr[n * 36 + 4 * (m ^ ((n >> 3) & 7)) + r] = pg8::cvt_pk_bf16(v[2 * m][e], v[2 * m + 1][e]); }
    LDS_WAIT(); asm volatile("" ::: "memory");
    const int q = lane & 7;
#pragma unroll
    for (int i = 0; i < 8; ++i) { const int nn = (lane >> 3) + 8 * i; const v4u w = *(const LAS v4u*)(scr + nn * 36 + 4 * (q ^ ((nn >> 3) & 7)));
        *(GAS v4u*)(d.WT + (size_t)(d.drow0 + nn) * d.K + d.k0 + 8 * q) = w; }
    LDS_WAIT(); asm volatile("" ::: "memory");
}
__device__ __forceinline__ void p0_transpose_item(const float* W, int K, int N, const float* ksc, bf16* WT, int k0, int n0, int drow0, LAS unsigned* scr, int lane) {
    const P0Item d{W, ksc, WT, K, N, k0, n0, drow0}; f32x4 v[16]; p0_load(d, v, lane); p0_finish(d, v, scr, lane);
}
__device__ __forceinline__ int il_row(int j, int h) { return (j >> 7) * 256 + h * 128 + (j & 127); }

constexpr int I_IN_ITEMS = (D / 64) * (NIN / 64), I_GV_ITEMS = (SW / 64) * (D / 64), I_OUT_ITEMS = (D / 64) * (D / 64), I_FI_ITEMS = (D / 64) * (2 * FF / 64), I_FO_ITEMS = (FF / 64) * (D / 64);
constexpr int I_MID_ITEMS = 3 * I_GV_ITEMS + I_OUT_ITEMS + I_FI_ITEMS, N_ITEMS = I_IN_ITEMS + I_MID_ITEMS + I_FO_ITEMS;
__device__ __forceinline__ int ffo_late_idle(int G) { pg8::StaticOrder S; S.init(M, 2 * FF, D, G, 0, 8); const int idle = (S.T.r == 0) ? S.T.R * G - S.nwg : 0; return idle >= 32 ? idle : 0; }
#ifndef P1_NG
#define P1_NG 224
#endif
#ifndef CONV1
#define CONV1 7168
#endif
__device__ __forceinline__ int p1_gemm_wgs(int G) { return (G == 256) ? P1_NG : G; }
__device__ __forceinline__ int p1_conv_items(int G) { return (p1_gemm_wgs(G) < G) ? (CONV1 < I_MID_ITEMS ? CONV1 : I_MID_ITEMS) : 0; }
__device__ __forceinline__ void p0_item(const Args& a, int it, LAS unsigned* scr, int lane) {
    unsigned char* ws = a.ws; constexpr int I_IN = I_IN_ITEMS, I_GV = I_GV_ITEMS, I_OUT = I_OUT_ITEMS, I_FI = I_FI_ITEMS;
    int r = it;
    if (r < I_IN) { const int nb = NIN / 64, kb = r / nb, n0 = 64 * (r % nb); p0_transpose_item(a.in[8], D, NIN, a.in[7], (bf16*)(ws + WS_WIN), 64 * kb, n0, n0, scr, lane); return; } r -= I_IN;
    if (r < I_GV) { const int nb = D / 64, kb = r / nb, n0 = 64 * (r % nb); p0_transpose_item(a.in[17], SW, D, nullptr, (bf16*)(ws + WS_WGB), 64 * kb, n0, il_row(n0, 0), scr, lane); return; } r -= I_GV;
    if (r < I_GV) { const int nb = D / 64, kb = r / nb, n0 = 64 * (r % nb); p0_transpose_item(a.in[18], SW, D, nullptr, (bf16*)(ws + WS_WGB), 64 * kb, n0, il_row(n0, 1), scr, lane); return; } r -= I_GV;
    if (r < I_GV) { const int nb = D / 64, kb = r / nb, n0 = 64 * (r % nb); p0_transpose_item(a.in[19], SW, D, nullptr, (bf16*)(ws + WS_WGB), 64 * kb, n0, 4096 + n0, scr, lane); return; } r -= I_GV;
    if (r < I_OUT) { const int nb = D / 64, kb = r / nb, n0 = 64 * (r % nb); p0_transpose_item(a.in[21], D, D, nullptr, (bf16*)(ws + WS_WOUT), 64 * kb, n0, n0, scr, lane); return; } r -= I_OUT;
    if (r < I_FI) { const int nb = 2 * FF / 64, kb = r / nb, n0 = 64 * (r % nb); const int dr = (n0 < FF) ? il_row(n0, 0) : il_row(n0 - FF, 1);
        p0_transpose_item(a.in[23], D, 2 * FF, a.in[22], (bf16*)(ws + WS_WFI), 64 * kb, n0, dr, scr, lane); return; } r -= I_FI;
    { const int nb = D / 64, kb = r / nb, n0 = 64 * (r % nb); p0_transpose_item(a.in[24], FF, D, nullptr, (bf16*)(ws + WS_WFO), 64 * kb, n0, n0, scr, lane); }
}
__device__ __forceinline__ void p0_prologue(const Frame& F, const Args& a) {
    unsigned char* ws = a.ws;
    LAS unsigned* scr = (LAS unsigned*)(F.lds + RING_OFF + F.wave * 16384);
    const int gw = F.vcu * NWAVES + F.wave, NGW = F.G * NWAVES;
    if (gw < NGRP) ssm_consts_item(a, gw, F.lane);
    const int cv = p1_conv_items(F.G), folate = ffo_late_idle(F.G) ? I_FO_ITEMS : 0;
    const int nmid = I_MID_ITEMS - cv, n0 = I_IN_ITEMS + nmid + (I_FO_ITEMS - folate);
    for (int j = gw; j < n0; j += NGW) p0_item(a, j < I_IN_ITEMS ? j : (j < I_IN_ITEMS + nmid ? j + cv : j + cv + folate), scr, F.lane);
    bf16* XB = (bf16*)(ws + WS_XB); float* rs1 = (float*)(ws + WS_RS1);
    for (int m0 = F.vcu * 32 + F.wave * 4; m0 < M; m0 += F.G * 32) for (int m = m0; m < m0 + 4; ++m) {
        const float* xrow = (m < MP) ? a.in[0] + (size_t)m * D : a.in[1] + (size_t)(m - MP) * D;
        const GAS f32x4* xr = (const GAS f32x4*)xrow + F.lane;
        f32x4 v[8]; float s = 0.f;
#pragma unroll
        for (int j = 0; j < 8; ++j) { v[j] = xr[64 * j]; s += (v[j].x * v[j].x + v[j].y * v[j].y) + (v[j].z * v[j].z + v[j].w * v[j].w); }
        s = wave_sum(s);
        GAS unsigned long long* o8 = (GAS unsigned long long*)(XB + (size_t)m * D) + F.lane;
#pragma unroll
        for (int j = 0; j < 8; ++j) o8[64 * j] = (unsigned long long)pk2(v[j].x, v[j].y) | ((unsigned long long)pk2(v[j].z, v[j].w) << 32);
        if (F.lane == 0) rs1[m] = 1.0f / sqrtf(s * (1.0f / D) + EPS);
    }
}

__device__ __forceinline__ void p7_phase(const Frame& F, const Args& a) {
    const int gw = F.vcu * NWAVES + F.wave, NGW = F.G * NWAVES;
    const float* RSS = (const float*)(a.ws + WS_RSS3); const float* gf = a.in[25]; const bf16* X2 = (const bf16*)(a.ws + WS_D);
    for (int m = gw; m < M; m += NGW) {
        const float pv = (F.lane < 32) ? RSS[((size_t)(F.lane >> 2) * M + m) * 4 + (F.lane & 3)] : 0.f;
        const GAS v4u* xr = (const GAS v4u*)(X2 + (size_t)m * D) + F.lane; v4u w[4];
#pragma unroll
        for (int j = 0; j < 4; ++j) w[j] = xr[64 * j];
        const float s = 1.0f / sqrtf(wave_sum(pv) * (1.0f / D) + EPS);
        GAS f32x4* yr = (GAS f32x4*)(a.out + (size_t)m * D); const GAS f32x4* gr = (const GAS f32x4*)gf;
#pragma unroll
        for (int j = 0; j < 4; ++j) { const int c4 = 2 * (64 * j + F.lane); pg8::f32x4 v0, v1; pg8::unpack8(__builtin_bit_cast(pg8::u32x4, w[j]), v0, v1);
            yr[c4] = v0 * s * gr[c4]; yr[c4 + 1] = v1 * s * gr[c4 + 1]; }
    }
}

#ifndef DBG_STOP
#define DBG_STOP 0
#endif
__device__ __forceinline__ void dbg_dump_bf16(const Frame& F, const Args& a, const bf16* src, int ld, int c0, int n) {
    const int gt = (F.vcu * NWAVES + F.wave) * 64 + F.lane, NGT = F.G * NWAVES * 64;
    for (size_t i = gt; i < (size_t)M * n; i += NGT) { const size_t r = i / n, j = i % n; a.out[r * D + c0 + j] = bf2f(src[r * ld + j]); }
}
__global__ void __launch_bounds__(NWAVES * 64, 2) mega_fwd(Args args) {
    extern __shared__ __attribute__((aligned(16))) unsigned char lds[];
    Frame F;
    F.lds = (LAS unsigned char*)lds;
    volatile LAS unsigned* MISC = (volatile LAS unsigned*)(F.lds + MISC_OFF);
    F.tid = threadIdx.x; F.lane = F.tid & 63; F.wave = __builtin_amdgcn_readfirstlane(F.tid >> 6);
    F.G = gridDim.x; { const int bx = blockIdx.x; F.vcu = (F.G % 8 == 0) ? (bx % 8) * (F.G / 8) + bx / 8 : bx; }
    unsigned char* ws = args.ws;
    gu32* ctl = (gu32*)(ws + WS_CTL);
    for (int u = F.tid; u < (LDS_BYTES - LDSCTL_OFF) / 4; u += NWAVES * 64) ((LAS unsigned*)(F.lds + LDSCTL_OFF))[u] = 0u;
    __syncthreads();
    const int lo = args.ph_lo, hi = args.ph_hi;
    const bool multi = (hi - lo) > 1;
    XcdBarrier bar; bar.bar = (unsigned*)(ctl + CW_BAR); bar.x = 0; bar.st = nullptr;
    if (multi) bar = xcd_barrier_post((unsigned*)(ctl + CW_BAR), MISC + 8);
#define IN(k) (lo <= (k) && (k) < hi)
#define SEAM(k) do { if (IN(k) && IN((k) + 1)) xcd_barrier(bar); } while (0)
    using namespace pg8;
#ifndef DUP_PHASE
#define DUP_PHASE -1
#endif
#define PH_BEGIN(k) if (IN(k)) { for (int rep_ = 0; rep_ < ((DUP_PHASE == (k)) ? 2 : 1); ++rep_) { if (rep_) xcd_barrier(bar);
#define PH_END(k) } SEAM(k); }
    PH_BEGIN(0) p0_prologue(F, args); PH_END(0)
    PH_BEGIN(1)
        const int ng1 = p1_gemm_wgs(F.G);
        if ((int)blockIdx.x >= ng1) {
            LAS unsigned* scr = (LAS unsigned*)(F.lds + RING_OFF + F.wave * 16384); const int cv = p1_conv_items(F.G), ncw = (F.G - ng1) * NWAVES;
            const float* w_gv0 = args.in[17]; const float* w_gv1 = args.in[18]; const float* w_gv2 = args.in[19]; const float* w_out = args.in[21]; const float* w_fi = args.in[23]; const float* k_fi = args.in[22];
            asm volatile("" : "+s"(w_gv0), "+s"(w_gv1), "+s"(w_gv2), "+s"(w_out), "+s"(w_fi), "+s"(k_fi));
            auto mid_item = [&](int k) -> P0Item {
                int r = k, sec, nb;
                if (r < I_GV_ITEMS) { sec = 1; nb = D / 64; } else { r -= I_GV_ITEMS;
                if (r < I_GV_ITEMS) { sec = 2; nb = D / 64; } else { r -= I_GV_ITEMS;
                if (r < I_GV_ITEMS) { sec = 3; nb = D / 64; } else { r -= I_GV_ITEMS;
                if (r < I_OUT_ITEMS) { sec = 4; nb = D / 64; } else { r -= I_OUT_ITEMS; sec = 5; nb = 2 * FF / 64; } } } }
                int kb = r / nb, n0 = 64 * (r - kb * nb);
                sec = __builtin_amdgcn_readfirstlane(sec); kb = __builtin_amdgcn_readfirstlane(kb); n0 = __builtin_amdgcn_readfirstlane(n0);
                P0Item d; d.k0 = 64 * kb; d.n0 = n0;
                d.W = sec == 1 ? w_gv0 : sec == 2 ? w_gv1 : sec == 3 ? w_gv2 : sec == 4 ? w_out : w_fi;
                d.ksc = sec == 5 ? k_fi : nullptr;
                d.WT = (bf16*)(ws + (sec <= 3 ? WS_WGB : sec == 4 ? WS_WOUT : WS_WFI));
                d.K = sec <= 3 ? SW : D; d.N = sec == 5 ? 2 * FF : D;
                d.drow0 = sec == 1 ? il_row(n0, 0) : sec == 2 ? il_row(n0, 1) : sec == 3 ? 4096 + n0 : sec == 4 ? n0 : ((n0 < FF) ? il_row(n0, 0) : il_row(n0 - FF, 1));
                return d; };
            f32x4 va[16], vb[16]; P0Item d0, d1;
            int k = ((int)blockIdx.x - ng1) * NWAVES + F.wave; bool h0 = k < cv;
            if (h0) { d0 = mid_item(k); p0_load(d0, va, F.lane); }
            while (h0) {
                const int k1 = k + ncw; const bool h1 = k1 < cv;
                if (h1) { d1 = mid_item(k1); p0_load(d1, vb, F.lane); }
                p0_finish(d0, va, scr, F.lane);
                if (!h1) break;
                k = k1 + ncw; h0 = k < cv;
                if (h0) { d0 = mid_item(k); p0_load(d0, va, F.lane); }
                p0_finish(d1, vb, scr, F.lane);
            }
        } else {
        Gemm g{(const bf16_t*)(ws + WS_XB), (const bf16_t*)(ws + WS_WIN), D}; StaticOrder S; S.init(M, NIN, D, ng1, (int)blockIdx.x, 8); const TailFix tf{(unsigned char*)args.out, (unsigned*)(ctl + CW_TAIL + 0 * 8192)};
        LAS float* rs1l = (LAS float*)(F.lds + RS2L_OFF);
        { const float* rs1g = (const float*)(ws + WS_RS1); Unit uu;
          float rv[8]; bool on[8];
#pragma unroll
          for (int ui = 0; ui < 8; ++ui) { on[ui] = S.next(ui, uu); rv[ui] = rs1g[(on[ui] ? uu.pm : 0) * BM + (F.tid & (BM - 1))]; }
#pragma unroll
          for (int ui = 0; ui < 8; ++ui) if (on[ui] && F.tid < BM) rs1l[ui * BM + F.tid] = rv[ui];
          LDS_WAIT(); __syncthreads(); }
        EpiIn E{(const PG8_LAS float*)rs1l, (bf16_t*)(ws + WS_U), (bf16_t*)(ws + WS_Q), (float*)(ws + WS_KF), (float*)(ws + WS_VF), (bf16_t*)(ws + WS_GT), (bf16_t*)(ws + WS_KB), (bf16_t*)(ws + WS_VT)};
        gemm_phase<EpiIn, StaticOrder, true, true, true>(F.lds + RING_OFF, g, S, E, tf);
        }
    PH_END(1)
    PH_BEGIN(2) p2a_phase(F, args); PH_END(2)
    PH_BEGIN(3) p2b_phase(F, args); PH_END(3)
    PH_BEGIN(4)
        Gemm g{(const bf16_t*)(ws + WS_G), (const bf16_t*)(ws + WS_WGB), SW}; TripleOrder S; S.init(M, D, SW, F.G, (int)blockIdx.x, 8); const TailFix tf{(unsigned char*)args.out, (unsigned*)(ctl + CW_TAIL + 1 * 8192)};
        EpiMix E{(const bf16_t*)(ws + WS_GT), (bf16_t*)(ws + WS_T), (bf16_t*)(ws + WS_D)};
        gemm_phase<EpiMix, TripleOrder, true, true, true>(F.lds + RING_OFF, g, S, E, tf);
    PH_END(4)
    PH_BEGIN(5)
        Gemm g{(const bf16_t*)(ws + WS_D), (const bf16_t*)(ws + WS_WOUT), D}; StaticOrder S; S.init(M, D, D, F.G, (int)blockIdx.x, 8); const TailFix tf{ws + WS_T, (unsigned*)(ctl + CW_TAIL + 2 * 8192)};
        EpiRes E{nullptr, nullptr, (const bf16_t*)(ws + WS_XB), nullptr, (bf16_t*)(ws + WS_X1B), (float*)(ws + WS_RSS2)};
        gemm_phase<EpiRes, StaticOrder, true, true, true>(F.lds + RING_OFF, g, S, E, tf);
    PH_END(5)
    PH_BEGIN(6)
        Gemm g{(const bf16_t*)(ws + WS_X1B), (const bf16_t*)(ws + WS_WFI), D}; StaticOrder S; S.init(M, 2 * FF, D, F.G, (int)blockIdx.x, 8); const TailFix tf{ws + WS_D, (unsigned*)(ctl + CW_TAIL + 4 * 8192)};
        LAS float* rs2l = (LAS float*)(F.lds + RS2L_OFF);
        { const f32x4* RQ = (const f32x4*)(ws + WS_RSS2); Unit uu; const int trow = F.lane >> 1, th = F.lane & 1;
          f32x4 q[8][4]; bool on[8];
#pragma unroll
          for (int ui = 0; ui < 8; ++ui) { on[ui] = S.next(ui, uu); const f32x4* rq = RQ + (size_t)(4 * th) * M + ((on[ui] ? uu.pm : 0) * BM + F.wave * 32 + trow);
              q[ui][0] = rq[0]; q[ui][1] = rq[M]; q[ui][2] = rq[2 * (size_t)M]; q[ui][3] = rq[3 * (size_t)M]; }
#pragma unroll
          for (int ui = 0; ui < 8; ++ui) { const f32x4 t = (q[ui][0] + q[ui][1]) + (q[ui][2] + q[ui][3]); float sm = (t[0] + t[1]) + (t[2] + t[3]); sm += __shfl_xor(sm, 1);
              if (on[ui] && th == 0) rs2l[ui * BM + F.wave * 32 + trow] = 1.0f / sqrtf(sm * (1.0f / D) + EPS); }
          LDS_WAIT(); __syncthreads(); }
        EpiFfn E{(const PG8_LAS float*)rs2l, (bf16_t*)(ws + WS_ACT)};
        gemm_phase<EpiFfn, StaticOrder, true, true>(F.lds + RING_OFF, g, S, E, tf);
        { const int nid = ffo_late_idle(F.G); const int c = (int)blockIdx.x, lastn = F.G - nid;
          if (nid && c >= lastn) { LAS unsigned* scr = (LAS unsigned*)(F.lds + RING_OFF + F.wave * 16384);
              for (int r = (c - lastn) * NWAVES + F.wave; r < I_FO_ITEMS; r += nid * NWAVES) { const int nb = D / 64, kb = r / nb, n0 = 64 * (r % nb);
                  p0_transpose_item(args.in[24], FF, D, nullptr, (bf16*)(ws + WS_WFO), 64 * kb, n0, n0, scr, F.lane); } } }
    PH_END(6)
    bool fused_final = false;
    if (IN(7)) {
        Gemm g{(const bf16_t*)(ws + WS_ACT), (const bf16_t*)(ws + WS_WFO), FF}; StaticOrder S; S.init(M, D, FF, F.G, (int)blockIdx.x, 8); const TailFix tf{ws + WS_C + (size_t)M * D * 2, (unsigned*)(ctl + CW_TAIL + 3 * 8192)};
        fused_final = multi && IN(8) && DUP_PHASE != 7 && S.T.R == 1 && S.T.r > 0 && S.T.s == 8;
        if (fused_final) {
            S.tfirst = true;
            EpiFinal E{(const bf16_t*)(ws + WS_X1B), (float*)(ws + WS_RSS3), args.out, args.in[25], (LAS float*)(F.lds + RS2L_OFF)};
            const GridSync gs{&bar};
            gemm_phase<EpiFinal, StaticOrder, true, true, true, GridSync>(F.lds + RING_OFF, g, S, E, tf, gs);
        } else {
            for (int rep_ = 0; rep_ < ((DUP_PHASE == 7) ? 2 : 1); ++rep_) { if (rep_) xcd_barrier(bar);
                EpiRes E{nullptr, nullptr, (const bf16_t*)(ws + WS_X1B), nullptr, (bf16_t*)(ws + WS_D), (float*)(ws + WS_RSS3)};
                gemm_phase<EpiRes, StaticOrder, true, true, true>(F.lds + RING_OFF, g, S, E, tf); }
            SEAM(7);
        }
    }
    if (!fused_final) { PH_BEGIN(8) p7_phase(F, args); PH_END(8) }
#undef IN
#undef SEAM
}

#ifndef MK_N_LAUNCHES
#define MK_N_LAUNCHES 1
#endif
extern "C" void kernel_launch(void* const* d_in, const int* in_sizes, int n_in, void* d_out, int out_size, void* d_ws, size_t ws_size, hipStream_t stream) {
    static int grid = 0;
    if (grid == 0) {
        if (n_in != 26 || (size_t)out_size != O_END || ws_size < WS_END) { fprintf(stderr, "kernel_launch: unexpected shapes: n_in %d out %d ws %zu (need %zu)\n", n_in, out_size, ws_size, (size_t)WS_END); grid = -1; return; }
        int dev = 0, cus = 0;
        if (hipGetDevice(&dev) != hipSuccess || hipDeviceGetAttribute(&cus, hipDeviceAttributeMultiprocessorCount, dev) != hipSuccess) { grid = -1; return; }
        if (hipFuncSetAttribute((const void*)mega_fwd, hipFuncAttributeMaxDynamicSharedMemorySize, LDS_BYTES) != hipSuccess) { fprintf(stderr, "kernel_launch: hipFuncSetAttribute failed\n"); grid = -1; return; }
        (void)hipGetLastError();
        grid = cus;
    }
    if (grid < 0) return;
    (void)hipMemsetAsync((char*)d_ws + WS_CTL, 0, CTL_ZERO_BYTES, stream);
    Args a{};
    for (int i = 0; i < 26; ++i) a.in[i] = (const float*)d_in[i];
    a.out = (float*)d_out; a.ws = (unsigned char*)d_ws;
    constexpr int NPH = 9;
    if (MK_N_LAUNCHES == 1) { a.ph_lo = 0; a.ph_hi = NPH; hipLaunchKernelGGL(mega_fwd, dim3(grid), dim3(NWAVES * 64), LDS_BYTES, stream, a); }
    else for (int p = 0; p < NPH; ++p) { a.ph_lo = p; a.ph_hi = p + 1; hipLaunchKernelGGL(mega_fwd, dim3(grid), dim3(NWAVES * 64), LDS_BYTES, stream, a); }
}
```

```cpp
#include <hip/hip_runtime.h>
#include <cstdio>
#include <cstdint>

constexpr int MP = 8192, MS = 512, M = MP + MS;
constexpr int D = 2048, SW = 1024, KVW = 256, NIN = 6656, FF = 5632;
constexpr int SEQ = 4096, NGRP = 64, NSTATE = 64, GCH = 16, NH = 16, HD = 64, NKV = 4, WIN = 128, DECB = 128, DECS = 4;
constexpr float EPS = 1e-6f;
constexpr size_t O_Y = 0, O_PRE = (size_t)M * D, O_PIM = O_PRE + 8192, O_PK = O_PIM + 8192, O_PV = O_PK + 65536, O_SRE = O_PV + 65536,
                 O_SIM = O_SRE + 524288, O_SK = O_SIM + 524288, O_SV = O_SK + 4194304, O_END = O_SV + 4194304;

namespace pg8 {
#define PG8_LAS __attribute__((address_space(3)))
typedef unsigned short bf16_t;
typedef short bf16x8 __attribute__((ext_vector_type(8)));
typedef float f32x4 __attribute__((ext_vector_type(4)));
typedef unsigned u32x4 __attribute__((ext_vector_type(4)));
constexpr int BM = 256, BK = 64, HALF = 128, HTB = HALF * BK * 2  , STAGE_BYTES = 8 * HTB, NXCD = 8, WGM = 8;

__host__ __device__ __forceinline__ int lds_byte(int r, int c) { const int st = (r >> 4) * 2 + (c >> 5), rr = r & 15, cc = c & 31, ob = rr * 64 + cc * 2; return st * 1024 + (ob ^ (((ob >> 9) & 1) << 5)); }
__host__ __device__ __forceinline__ void stage_rc(int b, int& R, int& C) { const int st = b / 1024, sb = b % 1024, swz = sb ^ (((sb >> 9) & 1) << 5); R = (st >> 1) * 16 + swz / 64; C = (st & 1) * 32 + (swz % 64) / 2; }
__host__ __device__ __forceinline__ int perm32(int rho) { const int n = rho >> 4, i = rho & 15; return 8 * (i >> 2) + 4 * n + (i & 3); }

struct Unit { int pm, pn, pa, pb, kind, kt0, nk, part, slab; };
struct Gemm { const bf16_t* A; const bf16_t* Bt; int K; };

__host__ __device__ __forceinline__ void map_tile(int wgid, int nM, int nN, int& pm, int& pn) {
    const int nwg = nM * nN;
    { const int q = nwg / NXCD, r = nwg % NXCD, xcd = wgid % NXCD, off = wgid / NXCD; wgid = (xcd < r ? xcd * (q + 1) : r * (q + 1) + (xcd - r) * q) + off; }
    const int nig = WGM * nN, gid = wgid / nig, fm = gid * WGM, gsz = (nM - fm) < WGM ? (nM - fm) : WGM;
    pm = fm + ((wgid % nig) % gsz); pn = (wgid % nig) / gsz;
}
struct TailPlan {
    int G, c, R, r, s, tu, tp;
    __host__ __device__ __forceinline__ void init(int nwg, int npairs, int G_, int c_, int smax) {
        G = G_; c = c_; R = nwg / G; r = nwg % G; s = 1; tu = -1; tp = 0;
        if (r > 0) { while (2 * s <= smax && 2 * s * r <= G && 2 * s <= npairs) s *= 2; }
        if (r > 0 && s == 1) { R += 1; r = 0; }
        if (r > 0) { int t, p; if (G % 8 == 0) { const int x = c % 8, y = c / 8; t = (y / s) * 8 + x; p = y % s; } else { t = c / s; p = c % s; }
            if (t < r) { tu = t; tp = p; } }
    }
    __device__ __forceinline__ void uni() { G = __builtin_amdgcn_readfirstlane(G); c = __builtin_amdgcn_readfirstlane(c); R = __builtin_amdgcn_readfirstlane(R); r = __builtin_amdgcn_readfirstlane(r);
        s = __builtin_amdgcn_readfirstlane(s); tu = __builtin_amdgcn_readfirstlane(tu); tp = __builtin_amdgcn_readfirstlane(tp); }
    __host__ __device__ __forceinline__ void krange(int nt, int& kt0, int& nk) const { const int pairs = nt / 2, k0 = tp * pairs / s, k1 = (tp + 1) * pairs / s; kt0 = 2 * k0; nk = 2 * (k1 - k0); }
};
struct StaticOrder {
    static constexpr bool TRIPLE = false;
    int nM, nN, nwg, nt; TailPlan T;
    __host__ __device__ __forceinline__ void init(int M_, int N_, int K_, int G_, int c_, int smax) { nM = M_ / BM; nN = N_ / BM; nwg = nM * nN; nt = K_ / BK; T.init(nwg, nt / 2, G_, c_, smax);
#if defined(__HIP_DEVICE_COMPILE__)
        T.uni();
#endif
    }
    bool tfirst = false;
    __host__ __device__ __forceinline__ bool next(int i, Unit& u) const {
        u.kind = i;
        if (tfirst) { const int np = T.tu >= 0 ? 1 : 0;
            if (i < np) { map_tile(T.R * T.G + T.tu, nM, nN, u.pm, u.pn); u.pa = u.pm; u.pb = u.pn; T.krange(nt, u.kt0, u.nk); u.part = T.tp; u.slab = T.tu * T.s + T.tp; return true; }
            const int j = i - np; if (j >= T.R) return false;
            const long L = (long)j * T.G + T.c; if (L >= nwg) return false; map_tile((int)L, nM, nN, u.pm, u.pn); u.pa = u.pm; u.pb = u.pn; u.kt0 = 0; u.nk = nt; u.part = -1; u.slab = 0; return true; }
        if (i < T.R) { const long L = (long)i * T.G + T.c; if (L >= nwg) return false; map_tile((int)L, nM, nN, u.pm, u.pn); u.pa = u.pm; u.pb = u.pn; u.kt0 = 0; u.nk = nt; u.part = -1; u.slab = 0; return true; }
        if (i == T.R && T.tu >= 0) { map_tile(T.R * T.G + T.tu, nM, nN, u.pm, u.pn); u.pa = u.pm; u.pb = u.pn; T.krange(nt, u.kt0, u.nk); u.part = T.tp; u.slab = T.tu * T.s + T.tp; return true; }
        return false;
    }
    __host__ __device__ __forceinline__ int nfix() const { return T.tu >= 0 ? 1 : 0; }
    __host__ __device__ __forceinline__ void fix(int f, Unit& u) const { (void)next(tfirst ? f : T.R + f, u); }
};
struct TripleOrder {
    static constexpr bool TRIPLE = true;
    int nM, nN, nwg, nt; TailPlan T;
    int mode3, tk, tq;
    __host__ __device__ __forceinline__ void init(int M_, int N_, int K_, int G_, int c_, int smax) { nM = M_ / BM; nN = N_ / BM; nwg = nM * nN; nt = K_ / BK; T.init(nwg, nt / 2, G_, c_, smax);
        mode3 = 0; tk = 0; tq = 0;
        if (T.r > 0 && G_ % 8 == 0 && T.r % 8 == 0 && (T.r / 8) * 12 <= G_ / 8 && nt % 8 == 0) {
            mode3 = 1; const int x = c_ % 8, y = c_ / 8, tl = y / 12, p = y % 12;
            if (tl < T.r / 8) { T.tu = tl * 8 + x; T.tp = p; tk = p >> 2; tq = p & 3; } else { T.tu = -1; T.tp = 0; } }
#if defined(__HIP_DEVICE_COMPILE__)
        T.uni(); mode3 = __builtin_amdgcn_readfirstlane(mode3); tk = __builtin_amdgcn_readfirstlane(tk); tq = __builtin_amdgcn_readfirstlane(tq);
#endif
    }
    __host__ __device__ __forceinline__ void fill(Unit& u, int sk) const { u.kind = sk; u.pa = (sk == 2) ? u.pm + nM : u.pm; u.pb = (sk == 2) ? 2 * nN + u.pn : 2 * u.pn + sk; }
    __host__ __device__ __forceinline__ bool next(int i, Unit& u) const {
        const int tr = i / 3, sk = i - 3 * tr;
        if (tr < T.R) { const long L = (long)tr * T.G + T.c; if (L >= nwg) return false; map_tile((int)L, nM, nN, u.pm, u.pn); fill(u, sk); u.kt0 = 0; u.nk = nt; u.part = -1; u.slab = 0; return true; }
        if (mode3) { if (i == 3 * T.R && T.tu >= 0) { map_tile(T.R * T.G + T.tu, nM, nN, u.pm, u.pn); fill(u, tk); u.kt0 = tq * (nt / 4); u.nk = nt / 4; u.part = tq; u.slab = (T.tu * 3 + tk) * 4 + tq; return true; }
            return false; }
        if (tr == T.R && T.tu >= 0) { map_tile(T.R * T.G + T.tu, nM, nN, u.pm, u.pn); fill(u, sk); T.krange(nt, u.kt0, u.nk); u.part = T.tp; u.slab = (T.tu * 3 + sk) * T.s + T.tp; return true; }
        return false;
    }
    __host__ __device__ __forceinline__ int nfix() const { return (mode3 == 0 && T.tu >= 0) ? 3 : 0; }
    __host__ __device__ __forceinline__ void fix(int f, Unit& u) const { (void)next(3 * T.R + f, u); }
};
struct TailFix { unsigned char* slabs; unsigned* cnt; };
__device__ __forceinline__ void uniformize(Unit& u) {
    u.pm = __builtin_amdgcn_readfirstlane(u.pm); u.pn = __builtin_amdgcn_readfirstlane(u.pn); u.pa = __builtin_amdgcn_readfirstlane(u.pa); u.pb = __builtin_amdgcn_readfirstlane(u.pb);
    u.kind = __builtin_amdgcn_readfirstlane(u.kind); u.kt0 = __builtin_amdgcn_readfirstlane(u.kt0); u.nk = __builtin_amdgcn_readfirstlane(u.nk);
    u.part = __builtin_amdgcn_readfirstlane(u.part); u.slab = __builtin_amdgcn_readfirstlane(u.slab);
}

typedef float f32x2_t __attribute__((ext_vector_type(2))); typedef __bf16 bf16x2_t __attribute__((ext_vector_type(2)));
__device__ __forceinline__ unsigned cvt_pk_bf16(float lo, float hi) { const f32x2_t v = {lo, hi}; const bf16x2_t b = __builtin_convertvector(v, bf16x2_t); return __builtin_bit_cast(unsigned, b); }
__device__ __forceinline__ u32x4 pack8(const f32x4 a, const f32x4 b) { u32x4 w; w.x = cvt_pk_bf16(a[0], a[1]); w.y = cvt_pk_bf16(a[2], a[3]); w.z = cvt_pk_bf16(b[0], b[1]); w.w = cvt_pk_bf16(b[2], b[3]); return w; }
__device__ __forceinline__ void unpack8(const u32x4 w, f32x4& a, f32x4& b) {
    a[0] = __uint_as_float(w.x << 16); a[1] = __uint_as_float(w.x & 0xffff0000u); a[2] = __uint_as_float(w.y << 16); a[3] = __uint_as_float(w.y & 0xffff0000u);
    b[0] = __uint_as_float(w.z << 16); b[1] = __uint_as_float(w.z & 0xffff0000u); b[2] = __uint_as_float(w.w << 16); b[3] = __uint_as_float(w.w & 0xffff0000u); }
__device__ __forceinline__ float sigmoidf_(float x) { return __builtin_amdgcn_rcpf(1.0f + __builtin_amdgcn_exp2f(-1.4426950408889634f * x)); }
__device__ __forceinline__ f32x4 sigmoid4(const f32x4 x) { f32x4 r; r[0] = sigmoidf_(x[0]); r[1] = sigmoidf_(x[1]); r[2] = sigmoidf_(x[2]); r[3] = sigmoidf_(x[3]); return r; }
__device__ __forceinline__ float sumsq4(const f32x4 x) { return (x[0] * x[0] + x[1] * x[1]) + (x[2] * x[2] + x[3] * x[3]); }

struct EpiIn {
    static constexpr bool PERM = true, FINAL = false;
    const PG8_LAS float* rs1;   bf16_t* U; bf16_t* Q; float* KF; float* VF; bf16_t* GT; bf16_t* KB; bf16_t* VT;
    __device__ __forceinline__ void operator()(const f32x4 (&acc)[2][2][4][2], const Unit& u, int wr, int wc, int fr, int fq, unsigned rg) const {
        const int row0 = u.pm * BM + wr * 64 + fr, cl = wc * 32 + 8 * fq, pn = u.pn;
#pragma unroll
        for (int ai = 0; ai < 2; ++ai)
#pragma unroll
            for (int m = 0; m < 4; ++m) { if (!((rg >> (ai * 4 + m)) & 1u)) continue; const int row = row0 + ai * HALF + m * 16; const float s = rs1[u.kind * BM + wr * 64 + ai * HALF + m * 16 + fr];
#pragma unroll
                for (int bj = 0; bj < 2; ++bj) { const int cb = bj * HALF + cl; f32x4 v0 = acc[ai][bj][m][0] * s, v1 = acc[ai][bj][m][1] * s;
                    if (pn < 4) { *(u32x4*)(U + (size_t)row * SW + pn * 256 + cb) = pack8(v0, v1); }
                    else if (pn < 8) { v0 = v0 * 0.125f; v1 = v1 * 0.125f; *(u32x4*)(Q + (size_t)row * SW + (pn - 4) * 256 + cb) = pack8(v0, v1); }
                    else if (pn == 8) { if (row >= MP || (row & (SEQ - 1)) >= SEQ - 128) { float* p = KF + (size_t)row * KVW + cb; *(f32x4*)p = v0; *(f32x4*)(p + 4) = v1; }
                        if (row < MP) { const int kvh = cb >> 6, dd = cb & 63, t = row & (SEQ - 1);
                            *(u32x4*)(KB + ((size_t)(((row >> 12) * 4 + kvh) * (SEQ / 32) + (t >> 5))) * 2048 + (dd >> 4) * 512 + ((((dd >> 3) & 1) * 32 + (t & 31)) * 8)) = pack8(v0, v1); } }
                    else if (pn == 9) { if (row >= MP || (row & (SEQ - 1)) >= SEQ - 128) { float* p = VF + (size_t)row * KVW + cb; *(f32x4*)p = v0; *(f32x4*)(p + 4) = v1; }
                        if (row < MP) { const int kvh = cb >> 6, d0 = cb & 63, t = row & (SEQ - 1), kk = t & 31, r16 = kk & 15;
                            bf16_t* vt = VT + ((size_t)(((row >> 12) * 4 + kvh) * (SEQ / 32) + (t >> 5))) * 2048 + ((kk >> 4) * 2 + (d0 >> 5)) * 512 + ((((r16 >> 2) & 1) * 32 + (d0 & 31)) * 8) + 4 * (r16 >> 3) + (r16 & 3);
                            const u32x4 w = pack8(v0, v1);
                            vt[0] = (bf16_t)(w.x & 0xffffu); vt[8] = (bf16_t)(w.x >> 16); vt[16] = (bf16_t)(w.y & 0xffffu); vt[24] = (bf16_t)(w.y >> 16);
                            vt[32] = (bf16_t)(w.z & 0xffffu); vt[40] = (bf16_t)(w.z >> 16); vt[48] = (bf16_t)(w.w & 0xffffu); vt[56] = (bf16_t)(w.w >> 16); } }
                    else { v0 = sigmoid4(v0); v1 = sigmoid4(v1); *(u32x4*)(GT + (size_t)row * (2 * D) + (pn - 10) * 256 + cb) = pack8(v0, v1); } } }
    }
};
struct EpiMix {
    static constexpr bool PERM = true, FINAL = false;
    const bf16_t* GT; bf16_t* T; bf16_t* MB;
    __device__ __forceinline__ void operator()(const f32x4 (&acc)[2][2][4][2], const Unit& u, int wr, int wc, int fr, int fq, unsigned rg) const {
        const int row0 = u.pm * BM + wr * 64 + fr, cl = wc * 32 + 8 * fq;
        if (u.kind < 2) {
            const int c = (2 * u.pn + u.kind) * HALF + cl;
#pragma unroll
            for (int ai = 0; ai < 2; ++ai)
#pragma unroll
                for (int m = 0; m < 4; ++m) { if (!((rg >> (ai * 4 + m)) & 1u)) continue; const int row = row0 + ai * HALF + m * 16;
                    f32x4 g0, g1; unpack8(*(const u32x4*)(GT + (size_t)row * (2 * D) + c), g0, g1);
                    const f32x4 t0 = g0 * acc[ai][0][m][0] * sigmoid4(acc[ai][1][m][0]), t1 = g1 * acc[ai][0][m][1] * sigmoid4(acc[ai][1][m][1]);
                    *(u32x4*)(T + (size_t)row * D + c) = pack8(t0, t1); }
        } else {
#pragma unroll
            for (int ai = 0; ai < 2; ++ai)
#pragma unroll
                for (int m = 0; m < 4; ++m) { if (!((rg >> (ai * 4 + m)) & 1u)) continue; const int row = row0 + ai * HALF + m * 16;
#pragma unroll
                    for (int bj = 0; bj < 2; ++bj) { const int c = u.pn * BM + bj * HALF + cl;
                        f32x4 g0, g1; unpack8(*(const u32x4*)(GT + (size_t)row * (2 * D) + D + c), g0, g1);
                        f32x4 t0, t1; unpack8(*(const u32x4*)(T + (size_t)row * D + c), t0, t1);
                        *(u32x4*)(MB + (size_t)row * D + c) = pack8(t0 + g0 * acc[ai][bj][m][0], t1 + g1 * acc[ai][bj][m][1]); } }
        }
    }
    __device__ __forceinline__ void fix3(const f32x4 (&vg)[2][2], const f32x4 (&wg)[2][2], const f32x4 (&br)[2][2], int pm, int pn, int wr, int wc, int fr, int fq, int ai, int m) const {
        const int row = pm * BM + wr * 64 + fr + ai * HALF + m * 16, cl = wc * 32 + 8 * fq;
#pragma unroll
        for (int bj = 0; bj < 2; ++bj) { const int c = pn * BM + bj * HALF + cl;
            f32x4 ga0, ga1, gb0, gb1; unpack8(*(const u32x4*)(GT + (size_t)row * (2 * D) + c), ga0, ga1); unpack8(*(const u32x4*)(GT + (size_t)row * (2 * D) + D + c), gb0, gb1);
            const f32x4 (&q)[2][2] = bj == 0 ? vg : wg;
            const f32x4 t0 = ga0 * q[0][0] * sigmoid4(q[1][0]), t1 = ga1 * q[0][1] * sigmoid4(q[1][1]);
            *(u32x4*)(MB + (size_t)row * D + c) = pack8(t0 + gb0 * br[bj][0], t1 + gb1 * br[bj][1]); }
    }
};
struct EpiRes {
    static constexpr bool PERM = true, FINAL = false;
    const float* xp; const float* xs; const bf16_t* rb; float* out; bf16_t* XB; float* RSS;
    __device__ __forceinline__ void operator()(const f32x4 (&acc)[2][2][4][2], const Unit& u, int wr, int wc, int fr, int fq, unsigned rg) const {
        const int row0 = u.pm * BM + wr * 64 + fr, cl = wc * 32 + 8 * fq;
        const float* rbase = (u.pm * BM < MP) ? xp : xs - (size_t)MP * D;
#pragma unroll
        for (int ai = 0; ai < 2; ++ai)
#pragma unroll
            for (int m = 0; m < 4; ++m) { if (!((rg >> (ai * 4 + m)) & 1u)) continue; const int row = row0 + ai * HALF + m * 16; float ss = 0.f;
#pragma unroll
                for (int bj = 0; bj < 2; ++bj) { const size_t off = (size_t)row * D + u.pn * BM + bj * HALF + cl;
                    f32x4 r0, r1; if (rb) unpack8(*(const u32x4*)(rb + off), r0, r1); else { r0 = *(const f32x4*)(rbase + off); r1 = *(const f32x4*)(rbase + off + 4); }
                    const f32x4 v0 = r0 + acc[ai][bj][m][0], v1 = r1 + acc[ai][bj][m][1];
                    ss += sumsq4(v0) + sumsq4(v1);
                    if (out) { *(f32x4*)(out + off) = v0; *(f32x4*)(out + off + 4) = v1; }
                    if (XB) *(u32x4*)(XB + off) = pack8(v0, v1); }
                ss += __shfl_xor(ss, 16); ss += __shfl_xor(ss, 32);
                if (fq == 0) RSS[((size_t)u.pn * M + row) * 4 + wc] = ss; }
    }
};
struct EpiFfn {
    static constexpr bool PERM = true, FINAL = false;
    const PG8_LAS float* RS; bf16_t* ACT;
    __device__ __forceinline__ void operator()(const f32x4 (&acc)[2][2][4][2], const Unit& u, int wr, int wc, int fr, int fq, unsigned rg) const {
        const int row0 = u.pm * BM + wr * 64 + fr, cl = wc * 32 + 8 * fq;
#pragma unroll
        for (int ai = 0; ai < 2; ++ai)
#pragma unroll
            for (int m = 0; m < 4; ++m) { if (!((rg >> (ai * 4 + m)) & 1u)) continue; const int row = row0 + ai * HALF + m * 16;
                const float s = RS[u.kind * BM + wr * 64 + ai * HALF + m * 16 + fr];
                const f32x4 g0 = acc[ai][0][m][0] * s, g1 = acc[ai][0][m][1] * s, u0 = acc[ai][1][m][0] * s, u1 = acc[ai][1][m][1] * s;
                *(u32x4*)(ACT + (size_t)row * FF + u.pn * HALF + cl) = pack8(g0 * sigmoid4(g0) * u0, g1 * sigmoid4(g1) * u1); }
    }
};
struct EpiFinal {
    static constexpr bool PERM = true, FINAL = true;
    const bf16_t* rb; float* RSS; float* out; const float* gf; PG8_LAS float* rt;
    __device__ __forceinline__ void pre_rg(f32x4& a00, f32x4& a01, f32x4& a10, f32x4& a11, int row, int pn, int cl, int wc, int fq) const {
        const size_t o0 = (size_t)row * D + pn * BM + cl, o1 = o0 + HALF;
        f32x4 r0, r1, r2, r3; unpack8(*(const u32x4*)(rb + o0), r0, r1); unpack8(*(const u32x4*)(rb + o1), r2, r3);
        a00 = a00 + r0; a01 = a01 + r1; a10 = a10 + r2; a11 = a11 + r3;
        float ss = (sumsq4(a00) + sumsq4(a01)) + (sumsq4(a10) + sumsq4(a11));
        ss += __shfl_xor(ss, 16); ss += __shfl_xor(ss, 32);
        if (fq == 0) RSS[((size_t)pn * M + row) * 4 + wc] = ss;
    }
    __device__ __forceinline__ void post_rg(const f32x4& a00, const f32x4& a01, const f32x4& a10, const f32x4& a11, int row, int pn, int cl, float r) const {
        const size_t o0 = (size_t)row * D + pn * BM + cl, o1 = o0 + HALF; const float* g0 = gf + pn * BM + cl; const float* g1 = g0 + HALF;
        *(f32x4*)(out + o0) = a00 * r * *(const f32x4*)g0; *(f32x4*)(out + o0 + 4) = a01 * r * *(const f32x4*)(g0 + 4);
        *(f32x4*)(out + o1) = a10 * r * *(const f32x4*)g1; *(f32x4*)(out + o1 + 4) = a11 * r * *(const f32x4*)(g1 + 4);
    }
};
struct NoSync { __device__ __forceinline__ void operator()() const {} };

template <class Epi, class Sched, bool ALIGN_EPI = false, bool SP2 = false, bool SLAB16 = false, class Sync = NoSync>
__device__ __forceinline__ void gemm_phase(PG8_LAS unsigned char* lds, const Gemm g, const Sched& S, const Epi& E, const TailFix tf, const Sync sync = Sync()) {
    const int tid = threadIdx.x, wid = __builtin_amdgcn_readfirstlane(tid >> 6), lane = tid & 63, wr = wid >> 2, wc = wid & 3, fr = lane & 15, fq = lane >> 4;
    const int K = g.K;
    unsigned voffA[2], voffB[2];
#pragma unroll
    for (int i = 0; i < 2; ++i) { int R, C; stage_rc(tid * 16 + i * 8192, R, C); const int Rb = Epi::PERM ? ((R & ~31) + perm32(R & 31)) : R;
        voffA[i] = (unsigned)(R * K + C) * 2u; voffB[i] = (unsigned)(Rb * K + C) * 2u; }
    const size_t kstep = (size_t)(BK * 2);
    const size_t hstep = (size_t)HALF * K * 2;
    const size_t tstep = 2 * hstep;
    const unsigned ldsw = (unsigned)wid * 1024u;
    const int aoff = lds_byte(wr * 64 + fr, fq * 8), boff = lds_byte(wc * 32 + fr, fq * 8);
#define PG8_SA(b, h) (((b) * 2 + (h)) * HTB)
#define PG8_SB(b, h) ((4 + (b) * 2 + (h)) * HTB)
#define PG8_STAGE(bufoff, gbase, voff) do { _Pragma("unroll") for (int _i = 0; _i < 2; ++_i) \
        __builtin_amdgcn_global_load_lds((const unsigned*)((const char*)(gbase) + (voff)[_i]), (PG8_LAS unsigned*)(lds + (bufoff) + ldsw + _i * 8192), 16, 0, 0); } while (0)
#define PG8_LDA(dst, b, h) do { _Pragma("unroll") for (int m = 0; m < 4; ++m) _Pragma("unroll") for (int k = 0; k < 2; ++k) dst[m][k] = *(const PG8_LAS bf16x8*)(lds + PG8_SA(b, h) + aoff + m * 2048 + k * 1024); } while (0)
#define PG8_LDB(dst, b, h) do { _Pragma("unroll") for (int n = 0; n < 2; ++n) _Pragma("unroll") for (int k = 0; k < 2; ++k) dst[n][k] = *(const PG8_LAS bf16x8*)(lds + PG8_SB(b, h) + boff + n * 2048 + k * 1024); } while (0)
#define PG8_MMA(ai, bj, At, Bt) do { __builtin_amdgcn_s_setprio(1); _Pragma("unroll") for (int m = 0; m < 4; ++m) _Pragma("unroll") for (int n = 0; n < 2; ++n) _Pragma("unroll") for (int k = 0; k < 2; ++k) \
        acc[ai][bj][m][n] = __builtin_amdgcn_mfma_f32_16x16x32_bf16(Bt[n][k], At[m][k], acc[ai][bj][m][n], 0, 0, 0); __builtin_amdgcn_s_setprio(0); } while (0)
#define PG8_WAIT_V(n) asm volatile("s_waitcnt vmcnt(" #n ")" ::: "memory")
#define PG8_WAIT_L(n) asm volatile("s_waitcnt lgkmcnt(" #n ")" ::: "memory")
#define PG8_BAR __builtin_amdgcn_s_barrier()
#define PG8_SCHED __builtin_amdgcn_sched_barrier(0)
    Unit cur, nxt; int ui = 0;
    if (!S.next(0, cur)) return;
    uniformize(cur);
    f32x4 acc[2][2][4][2];
#pragma unroll
    for (int a = 0; a < 2; ++a)
#pragma unroll
        for (int b = 0; b < 2; ++b)
#pragma unroll
            for (int m = 0; m < 4; ++m)
#pragma unroll
                for (int n = 0; n < 2; ++n) acc[a][b][m][n] = (f32x4){0.f, 0.f, 0.f, 0.f};
    bf16x8 At[4][2], B0[2][2], B1[2][2];
    const char* cA = (const char*)g.A + (size_t)cur.pa * tstep + (size_t)cur.kt0 * kstep; const char* cB = (const char*)g.Bt + (size_t)cur.pb * tstep + (size_t)cur.kt0 * kstep;
    if constexpr (SP2) {
        PG8_STAGE(PG8_SB(0, 0), cB, voffB); PG8_STAGE(PG8_SB(0, 1), cB + hstep, voffB); PG8_STAGE(PG8_SA(0, 0), cA, voffA); PG8_STAGE(PG8_SA(0, 1), cA + hstep, voffA);
        if (wr == 1) PG8_BAR;
        PG8_WAIT_V(2); PG8_BAR;
        PG8_STAGE(PG8_SB(1, 0), cB + kstep, voffB); PG8_STAGE(PG8_SA(1, 0), cA + kstep, voffA); PG8_STAGE(PG8_SB(1, 1), cB + hstep + kstep, voffB);
        PG8_WAIT_V(6); PG8_BAR;
    } else {
        PG8_STAGE(PG8_SB(0, 0), cB, voffB); PG8_STAGE(PG8_SA(0, 0), cA, voffA); PG8_STAGE(PG8_SB(0, 1), cB + hstep, voffB); PG8_STAGE(PG8_SA(0, 1), cA + hstep, voffA);
        if (wr == 1) PG8_BAR;
        PG8_WAIT_V(4); PG8_BAR;
        PG8_STAGE(PG8_SB(1, 0), cB + kstep, voffB); PG8_STAGE(PG8_SA(1, 0), cA + kstep, voffA); PG8_STAGE(PG8_SB(1, 1), cB + hstep + kstep, voffB);
        PG8_WAIT_V(6); PG8_BAR;
    }
    for (;;) {
        const bool has_next = S.next(ui + 1, nxt); if (has_next) uniformize(nxt);
        const char* nA = has_next ? (const char*)g.A + (size_t)nxt.pa * tstep + (size_t)nxt.kt0 * kstep : cA; const char* nB = has_next ? (const char*)g.Bt + (size_t)nxt.pb * tstep + (size_t)nxt.kt0 * kstep : cB;
        const int nt = cur.nk;
        for (int t = 0; t < nt; t += 2) {
            const bool last = (t == nt - 2);
            const char* a1 = cA + (size_t)(t + 1) * kstep;
            const char* a2 = last ? nA : cA + (size_t)(t + 2) * kstep; const char* b2 = last ? nB : cB + (size_t)(t + 2) * kstep;
            const char* a3 = a2 + kstep; const char* b3 = b2 + kstep;
            if constexpr (SP2) {
            PG8_LDB(B0, 0, 0); PG8_LDB(B1, 0, 1); PG8_SCHED; PG8_LDA(At, 0, 0); PG8_STAGE(PG8_SA(1, 1), a1 + hstep, voffA);
            PG8_WAIT_V(8); PG8_WAIT_L(0); PG8_BAR; PG8_MMA(0, 0, At, B0); PG8_MMA(0, 1, At, B1); PG8_BAR; PG8_SCHED;
            PG8_LDA(At, 0, 1); PG8_STAGE(PG8_SB(0, 0), b2, voffB); PG8_STAGE(PG8_SB(0, 1), b2 + hstep, voffB); PG8_STAGE(PG8_SA(0, 0), a2, voffA);
            PG8_WAIT_V(8); PG8_WAIT_L(0); PG8_BAR; PG8_MMA(1, 0, At, B0); PG8_MMA(1, 1, At, B1); PG8_BAR; PG8_SCHED;
            PG8_LDB(B0, 1, 0); PG8_LDB(B1, 1, 1); PG8_SCHED; PG8_LDA(At, 1, 0); PG8_STAGE(PG8_SA(0, 1), a2 + hstep, voffA);
            PG8_WAIT_V(8); PG8_WAIT_L(0); PG8_BAR; PG8_MMA(0, 0, At, B0); PG8_MMA(0, 1, At, B1); PG8_BAR; PG8_SCHED;
            PG8_LDA(At, 1, 1); PG8_STAGE(PG8_SB(1, 0), b3, voffB); PG8_STAGE(PG8_SB(1, 1), b3 + hstep, voffB); PG8_STAGE(PG8_SA(1, 0), a3, voffA);
            PG8_WAIT_V(8); PG8_WAIT_L(0); PG8_BAR; PG8_MMA(1, 0, At, B0); PG8_MMA(1, 1, At, B1); PG8_BAR; PG8_SCHED;
            } else {
            PG8_LDB(B0, 0, 0); PG8_SCHED; PG8_LDA(At, 0, 0); PG8_STAGE(PG8_SA(1, 1), a1 + hstep, voffA);
            PG8_WAIT_L(8); PG8_BAR; PG8_WAIT_L(0); PG8_MMA(0, 0, At, B0); PG8_BAR; PG8_SCHED;
            PG8_LDB(B1, 0, 1); PG8_STAGE(PG8_SB(0, 0), b2, voffB);
            PG8_BAR; PG8_WAIT_L(0); PG8_MMA(0, 1, At, B1); PG8_BAR;
            PG8_LDA(At, 0, 1); PG8_STAGE(PG8_SA(0, 0), a2, voffA);
            PG8_BAR; PG8_WAIT_L(0); PG8_MMA(1, 0, At, B0); PG8_BAR; PG8_SCHED;
            PG8_STAGE(PG8_SB(0, 1), b2 + hstep, voffB);
            PG8_WAIT_V(6); PG8_BAR; PG8_MMA(1, 1, At, B1); PG8_BAR;
            PG8_LDB(B0, 1, 0); PG8_SCHED; PG8_LDA(At, 1, 0); PG8_STAGE(PG8_SA(0, 1), a2 + hstep, voffA);
            PG8_WAIT_L(8); PG8_BAR; PG8_WAIT_L(0); PG8_MMA(0, 0, At, B0); PG8_BAR; PG8_SCHED;
            PG8_LDB(B1, 1, 1); PG8_STAGE(PG8_SB(1, 0), b3, voffB);
            PG8_BAR; PG8_WAIT_L(0); PG8_MMA(0, 1, At, B1); PG8_BAR;
            PG8_LDA(At, 1, 1); PG8_STAGE(PG8_SA(1, 0), a3, voffA);
            PG8_BAR; PG8_WAIT_L(0); PG8_MMA(1, 0, At, B0); PG8_BAR; PG8_SCHED;
            PG8_STAGE(PG8_SB(1, 1), b3 + hstep, voffB);
            PG8_WAIT_V(6); PG8_BAR; PG8_MMA(1, 1, At, B1); PG8_BAR;
            }
        }
        if constexpr (ALIGN_EPI) { if (wr == 0) PG8_BAR; }
        int fr_e = fr, fq_e = fq, tid_e = tid; asm volatile("" : "+v"(fr_e), "+v"(fq_e), "+v"(tid_e));
        if (cur.part < 0) { if constexpr (!Epi::FINAL) E(acc, cur, wr, wc, fr_e, fq_e, 0xffu); }
        else {
            const __amdgpu_buffer_rsrc_t srs = __builtin_amdgcn_make_buffer_rsrc((void*)tf.slabs, (short)0, 0x7ffff000, 0x00020000);
            constexpr unsigned SLB = SLAB16 ? 131072u : 262144u;
            unsigned so = (unsigned)cur.slab * SLB + (unsigned)tid_e * 16u;
#pragma unroll
            for (int a = 0; a < 2; ++a)
#pragma unroll
                for (int b = 0; b < 2; ++b)
#pragma unroll
                    for (int m = 0; m < 4; ++m) {
                        if constexpr (SLAB16) { __builtin_amdgcn_raw_buffer_store_b128(pack8(acc[a][b][m][0], acc[a][b][m][1]), srs, so, 0, 16); so += 8192u; asm volatile("" : "+v"(so)); }
                        else {
#pragma unroll
                            for (int n = 0; n < 2; ++n) { __builtin_amdgcn_raw_buffer_store_b128(__builtin_bit_cast(u32x4, acc[a][b][m][n]), srs, so, 0, 16); so += 8192u; asm volatile("" : "+v"(so)); } } }
        }
        if (!has_next) break;
#pragma unroll
        for (int a = 0; a < 2; ++a)
#pragma unroll
            for (int b = 0; b < 2; ++b)
#pragma unroll
                for (int m = 0; m < 4; ++m)
#pragma unroll
                    for (int n = 0; n < 2; ++n) acc[a][b][m][n] = (f32x4){0.f, 0.f, 0.f, 0.f};
        cur = nxt; cA = nA; cB = nB; ++ui;
        if constexpr (ALIGN_EPI) { if (wr == 1) PG8_BAR; }
    }
    PG8_WAIT_V(0);
    if constexpr (!ALIGN_EPI) { if (wr == 0) PG8_BAR; }
    PG8_BAR;
    if constexpr (Epi::FINAL) {
        int fr_f = fr, fq_f = fq, tid_f = tid; asm volatile("" : "+v"(fr_f), "+v"(fq_f), "+v"(tid_f));
        const int cl = wc * 32 + 8 * fq_f, row0 = cur.pm * BM + wr * 64 + fr_f;
#pragma unroll
        for (int ai = 0; ai < 2; ++ai)
#pragma unroll
            for (int m = 0; m < 4; ++m) E.pre_rg(acc[ai][0][m][0], acc[ai][0][m][1], acc[ai][1][m][0], acc[ai][1][m][1], row0 + ai * HALF + m * 16, cur.pn, cl, wc, fq_f);
        f32x4 p00 = {0.f, 0.f, 0.f, 0.f}, p01 = p00, p10 = p00, p11 = p00; Unit fu = cur; int prow = 0; const bool hasfix = S.nfix() > 0;
        if (hasfix) {
            const int sN = S.T.s;
            asm volatile("s_waitcnt vmcnt(0)" ::: "memory"); __syncthreads();
            if (tid == 0) { unsigned* cw = tf.cnt + 64 * S.T.tu; __hip_atomic_fetch_add(cw, 1u, __ATOMIC_RELAXED, __HIP_MEMORY_SCOPE_AGENT); unsigned sp = 0;
                while (__hip_atomic_load(cw, __ATOMIC_RELAXED, __HIP_MEMORY_SCOPE_AGENT) < (unsigned)sN) { __builtin_amdgcn_s_sleep(2); if (++sp > (1u << 22)) break; }
                __builtin_amdgcn_fence(__ATOMIC_ACQUIRE, "agent"); asm volatile("s_waitcnt vmcnt(0)" ::: "memory"); }
            __syncthreads();
            S.fix(0, fu); uniformize(fu);
            const int fai = S.T.tp >> 2, fm = S.T.tp & 3;
            const __amdgpu_buffer_rsrc_t srs = __builtin_amdgcn_make_buffer_rsrc((void*)tf.slabs, (short)0, 0x7ffff000, 0x00020000);
            const unsigned sl0 = (unsigned)(fu.slab - fu.part) * 131072u + (unsigned)tid_f * 16u;
#pragma unroll
            for (int b = 0; b < 2; ++b) { unsigned p = sl0 + (unsigned)((fai * 2 + b) * 4 + fm) * 8192u; asm volatile("" : "+v"(p));
                f32x4 v0, v1; unpack8(__builtin_amdgcn_raw_buffer_load_b128(srs, p, 0, 16), v0, v1);
                { u32x4 wq[7];
#pragma unroll
                  for (int j = 1; j < 8; ++j) { wq[j - 1] = (j < sN) ? __builtin_amdgcn_raw_buffer_load_b128(srs, p + (unsigned)j * 131072u, 0, 16) : (u32x4){0u, 0u, 0u, 0u}; }
#pragma unroll
                  for (int j = 1; j < 8; ++j) { f32x4 w0, w1; unpack8(wq[j - 1], w0, w1); v0 = v0 + w0; v1 = v1 + w1; } }
                if (b == 0) { p00 = v0; p01 = v1; } else { p10 = v0; p11 = v1; } }
            prow = fu.pm * BM + wr * 64 + fr_f + fai * HALF + fm * 16;
            E.pre_rg(p00, p01, p10, p11, prow, fu.pn, cl, wc, fq_f);
        }
        sync();
        {
            const int trow = lane >> 1, th = lane & 1;
            const f32x4* rq = (const f32x4*)E.RSS + (size_t)(4 * th) * M + (cur.pm * BM + wid * 32 + trow);
            f32x4 q0 = rq[0], q1 = rq[M], q2 = rq[2 * (size_t)M], q3 = rq[3 * (size_t)M];
            f32x4 z0 = {0.f, 0.f, 0.f, 0.f}, z1 = z0, z2 = z0, z3 = z0;
            if (hasfix && wid == 0) { const int fai = S.T.tp >> 2, fm = S.T.tp & 3; const int prw = fu.pm * BM + fai * HALF + (trow >> 4) * 64 + fm * 16 + (trow & 15);
                const f32x4* pq = (const f32x4*)E.RSS + (size_t)(4 * th) * M + prw; z0 = pq[0]; z1 = pq[M]; z2 = pq[2 * (size_t)M]; z3 = pq[3 * (size_t)M]; }
            q0 = (q0 + q1) + (q2 + q3); float sm = (q0[0] + q0[1]) + (q0[2] + q0[3]); sm += __shfl_xor(sm, 1);
            if (th == 0) E.rt[wid * 32 + trow] = 1.0f / sqrtf(sm * (1.0f / D) + EPS);
            if (hasfix && wid == 0) { z0 = (z0 + z1) + (z2 + z3); float sp2 = (z0[0] + z0[1]) + (z0[2] + z0[3]); sp2 += __shfl_xor(sp2, 1); if (th == 0) E.rt[256 + trow] = 1.0f / sqrtf(sp2 * (1.0f / D) + EPS); }
            asm volatile("s_waitcnt lgkmcnt(0)" ::: "memory"); __syncthreads();
        }
        {
            const int ccol = (wc * 32 + fq_f * 8) >> 2;
#pragma unroll
            for (int ai = 0; ai < 2; ++ai) {
#pragma unroll
                for (int m = 0; m < 4; ++m) { const int rloc = wr * 64 + m * 16 + fr_f; PG8_LAS unsigned char* rowp = lds + rloc * 1024;
#pragma unroll
                    for (int bj = 0; bj < 2; ++bj)
#pragma unroll
                        for (int n = 0; n < 2; ++n) *(PG8_LAS f32x4*)(rowp + (((bj * 32 + ccol + n) ^ (rloc & 7)) * 16)) = acc[ai][bj][m][n]; }
                asm volatile("s_waitcnt lgkmcnt(0)" ::: "memory"); __syncthreads();
                const f32x4 g4 = *(const f32x4*)(E.gf + cur.pn * BM + 4 * lane);
#pragma unroll 4
                for (int k = 0; k < 16; ++k) { const int rloc = wid * 16 + k; const f32x4 v = *(const PG8_LAS f32x4*)(lds + rloc * 1024 + ((lane ^ (rloc & 7)) * 16));
                    const float r = E.rt[ai * HALF + rloc];
                    *(f32x4*)(E.out + (size_t)(cur.pm * BM + ai * HALF + rloc) * D + cur.pn * BM + 4 * lane) = v * r * g4; }
                asm volatile("s_waitcnt lgkmcnt(0)" ::: "memory"); __syncthreads();
            }
            if (hasfix) {
                const int rloc = wr * 16 + fr_f; PG8_LAS unsigned char* rowp = lds + rloc * 1024;
                *(PG8_LAS f32x4*)(rowp + (((ccol) ^ (rloc & 7)) * 16)) = p00; *(PG8_LAS f32x4*)(rowp + (((ccol + 1) ^ (rloc & 7)) * 16)) = p01;
                *(PG8_LAS f32x4*)(rowp + (((32 + ccol) ^ (rloc & 7)) * 16)) = p10; *(PG8_LAS f32x4*)(rowp + (((32 + ccol + 1) ^ (rloc & 7)) * 16)) = p11;
                asm volatile("s_waitcnt lgkmcnt(0)" ::: "memory"); __syncthreads();
                const f32x4 g4 = *(const f32x4*)(E.gf + fu.pn * BM + 4 * lane); const int fai = S.T.tp >> 2, fm = S.T.tp & 3;
#pragma unroll
                for (int k = 0; k < 4; ++k) { const int rl = wid * 4 + k; const f32x4 v = *(const PG8_LAS f32x4*)(lds + rl * 1024 + ((lane ^ (rl & 7)) * 16));
                    const float r = E.rt[256 + rl]; const int grow = fu.pm * BM + fai * HALF + (rl >> 4) * 64 + fm * 16 + (rl & 15);
                    *(f32x4*)(E.out + (size_t)grow * D + fu.pn * BM + 4 * lane) = v * r * g4; }
            }
        }
    }
    if constexpr (Sched::TRIPLE) if (S.mode3 && S.T.tu >= 0) {
        int fr_f = fr, fq_f = fq, tid_f = tid; asm volatile("" : "+v"(fr_f), "+v"(fq_f), "+v"(tid_f));
        const int rgi = S.T.tp;
        asm volatile("s_waitcnt vmcnt(0)" ::: "memory"); __syncthreads();
        if (tid == 0) {
            unsigned* cw = tf.cnt + 64 * S.T.tu;
            __hip_atomic_fetch_add(cw, 1u, __ATOMIC_RELAXED, __HIP_MEMORY_SCOPE_AGENT);
            if (rgi < 8) { unsigned sp = 0;
                while (__hip_atomic_load(cw, __ATOMIC_RELAXED, __HIP_MEMORY_SCOPE_AGENT) < 12u) { __builtin_amdgcn_s_sleep(2); if (++sp > (1u << 22)) break; }
                __builtin_amdgcn_fence(__ATOMIC_ACQUIRE, "agent"); asm volatile("s_waitcnt vmcnt(0)" ::: "memory"); }
        }
        __syncthreads();
        if (rgi < 8) {
            const int fa = rgi >> 2, fm = rgi & 3;
            const __amdgpu_buffer_rsrc_t srs = __builtin_amdgcn_make_buffer_rsrc((void*)tf.slabs, (short)0, 0x7ffff000, 0x00020000);
            static_assert(SLAB16 || !Sched::TRIPLE, "triple parts keep bf16 slabs");
            u32x4 w[3][2][4];
#pragma unroll
            for (int k = 0; k < 3; ++k)
#pragma unroll
                for (int b = 0; b < 2; ++b)
#pragma unroll
                    for (int q = 0; q < 4; ++q) w[k][b][q] = __builtin_amdgcn_raw_buffer_load_b128(srs, (unsigned)(((S.T.tu * 3 + k) * 4 + q)) * 131072u + (unsigned)((fa * 2 + b) * 4 + fm) * 8192u + (unsigned)tid_f * 16u, 0, 16);
            f32x4 sm[3][2][2];
#pragma unroll
            for (int k = 0; k < 3; ++k)
#pragma unroll
                for (int b = 0; b < 2; ++b) { f32x4 v0, v1; unpack8(w[k][b][0], v0, v1);
#pragma unroll
                    for (int q = 1; q < 4; ++q) { f32x4 x0, x1; unpack8(w[k][b][q], x0, x1); v0 = v0 + x0; v1 = v1 + x1; }
                    sm[k][b][0] = v0; sm[k][b][1] = v1; }
            int pm_, pn_; map_tile(S.T.R * S.T.G + S.T.tu, S.nM, S.nN, pm_, pn_); pm_ = __builtin_amdgcn_readfirstlane(pm_); pn_ = __builtin_amdgcn_readfirstlane(pn_);
            E.fix3(sm[0], sm[1], sm[2], pm_, pn_, wr, wc, fr_f, fq_f, fa, fm);
        }
    }
    if constexpr (!Epi::FINAL) if (S.nfix() > 0) {
        const int sN = S.T.s;
        int fr_f = fr, fq_f = fq, tid_f = tid; asm volatile("" : "+v"(fr_f), "+v"(fq_f), "+v"(tid_f));
        asm volatile("s_waitcnt vmcnt(0)" ::: "memory"); __syncthreads();
        if (tid == 0) {
            unsigned* cw = tf.cnt + 64 * S.T.tu;
            __hip_atomic_fetch_add(cw, 1u, __ATOMIC_RELAXED, __HIP_MEMORY_SCOPE_AGENT);
            unsigned sp = 0;
            while (__hip_atomic_load(cw, __ATOMIC_RELAXED, __HIP_MEMORY_SCOPE_AGENT) < (unsigned)sN) { __builtin_amdgcn_s_sleep(2); if (++sp > (1u << 22)) break; }
            __builtin_amdgcn_fence(__ATOMIC_ACQUIRE, "agent"); asm volatile("s_waitcnt vmcnt(0)" ::: "memory");
        }
        __syncthreads();
        const int per = 8 / sN; const unsigned rg = ((1u << per) - 1u) << (per * S.T.tp);
        for (int f = 0; f < S.nfix(); ++f) {
            Unit fu; S.fix(f, fu); uniformize(fu);
            const __amdgpu_buffer_rsrc_t srs = __builtin_amdgcn_make_buffer_rsrc((void*)tf.slabs, (short)0, 0x7ffff000, 0x00020000);
            constexpr unsigned SLB = SLAB16 ? 131072u : 262144u;
            const unsigned sl0 = (unsigned)(fu.slab - fu.part) * SLB + (unsigned)tid_f * 16u;
#pragma unroll
            for (int a = 0; a < 2; ++a)
#pragma unroll
                for (int m = 0; m < 4; ++m) { if (!((rg >> (a * 4 + m)) & 1u)) continue;
#pragma unroll
                    for (int b = 0; b < 2; ++b) {
                        if constexpr (SLAB16) { unsigned p = sl0 + (unsigned)((a * 2 + b) * 4 + m) * 8192u; asm volatile("" : "+v"(p));
                            f32x4 v0, v1; unpack8(__builtin_amdgcn_raw_buffer_load_b128(srs, p, 0, 16), v0, v1);
                            { u32x4 wq[7];
#pragma unroll
                              for (int j = 1; j < 8; ++j) { wq[j - 1] = (j < sN) ? __builtin_amdgcn_raw_buffer_load_b128(srs, p + (unsigned)j * SLB, 0, 16) : (u32x4){0u, 0u, 0u, 0u}; }
#pragma unroll
                              for (int j = 1; j < 8; ++j) { f32x4 w0, w1; unpack8(wq[j - 1], w0, w1); v0 = v0 + w0; v1 = v1 + w1; } }
                            acc[a][b][m][0] = v0; acc[a][b][m][1] = v1; }
                        else {
#pragma unroll
                            for (int n = 0; n < 2; ++n) { unsigned p = sl0 + (unsigned)(((a * 2 + b) * 4 + m) * 2 + n) * 8192u; asm volatile("" : "+v"(p));
                                f32x4 v = __builtin_bit_cast(f32x4, __builtin_amdgcn_raw_buffer_load_b128(srs, p, 0, 16));
                                for (int j = 1; j < sN; ++j) { p += SLB; v = v + __builtin_bit_cast(f32x4, __builtin_amdgcn_raw_buffer_load_b128(srs, p, 0, 16)); } acc[a][b][m][n] = v; } } } }
            E(acc, fu, wr, wc, fr_f, fq_f, rg);
        }
    }
#undef PG8_SA
#undef PG8_SB
#undef PG8_STAGE
#undef PG8_LDA
#undef PG8_LDB
#undef PG8_MMA
#undef PG8_WAIT_V
#undef PG8_WAIT_L
#undef PG8_BAR
#undef PG8_SCHED
}
}

constexpr size_t MiB = 1u << 20;
constexpr size_t WS_CTL = 0, CTL_ZERO_BYTES = 1 * MiB;
constexpr size_t WS_WIN = 1 * MiB;
constexpr size_t WS_WGB = WS_WIN + (size_t)NIN * D * 2;
constexpr size_t WS_WOUT = WS_WGB + (size_t)6144 * SW * 2;
constexpr size_t WS_WFI = WS_WOUT + (size_t)D * D * 2;
constexpr size_t WS_WFO = WS_WFI + (size_t)2 * FF * D * 2;
constexpr size_t WS_A = WS_WFO + (size_t)D * FF * 2;
constexpr size_t WS_XB = WS_A, WS_U = WS_A + (size_t)M * D * 2, WS_Q = WS_U + (size_t)M * SW * 2, WS_T = WS_A + (size_t)M * D * 2;
constexpr size_t WS_B = WS_A + (size_t)M * D * 4;
constexpr size_t WS_KF = WS_B, WS_VF = WS_KF + (size_t)M * KVW * 4, WS_G = WS_VF + (size_t)M * KVW * 4, WS_O = WS_G + (size_t)M * SW * 2;
constexpr size_t WS_C = WS_O + (size_t)M * SW * 2;
constexpr size_t WS_GT = WS_C, WS_X1B = WS_C;
constexpr size_t WS_D = WS_C + (size_t)M * 2 * D * 2;
constexpr size_t WS_E = WS_D + (size_t)M * D * 2;
constexpr size_t WS_RS1 = WS_E, WS_RSS2 = WS_RS1 + (size_t)M * 4, WS_RSS3 = WS_RSS2 + (size_t)M * 32 * 4, WS_KB = WS_RSS3 + (size_t)M * 32 * 4, WS_VT = WS_KB + (size_t)M * KVW * 2,
                 WS_SSMC = WS_VT + (size_t)2 * KVW * SEQ * 2, WS_HLOC = WS_SSMC + (size_t)64 * 2304 * 4, WS_END = WS_HLOC + (size_t)2 * 64 * 16 * 128 * 4;
constexpr size_t WS_ACT = WS_A;
static_assert((size_t)M * FF * 2 <= WS_C - WS_A, "act overlay");
static_assert(WS_O == WS_G + (size_t)M * SW * 2, "g and o contiguous (A tile select in P3)");
constexpr int CW_BAR = 4096, CW_TAIL = 16384;

constexpr int RING_OFF = 0, RING_BYTES = 131072;
constexpr int LDSCTL_OFF = RING_BYTES, MISC_OFF = LDSCTL_OFF + 320;
constexpr int RS2L_OFF = 131072 + 1024;
constexpr int LDS_BYTES = 147456;
constexpr int NWAVES = 8;

#define GAS __attribute__((address_space(1)))
#define LAS __attribute__((address_space(3)))
typedef unsigned short bf16;
typedef unsigned v4u __attribute__((ext_vector_type(4)));
typedef float f32x4 __attribute__((ext_vector_type(4)));
typedef GAS unsigned gu32;
#define RLX_AGENT __ATOMIC_RELAXED, __HIP_MEMORY_SCOPE_AGENT
#define LDS_WAIT() asm volatile("s_waitcnt lgkmcnt(0)" ::: "memory")
#define VM_WAIT() asm volatile("s_waitcnt vmcnt(0)" ::: "memory")
__device__ __forceinline__ unsigned f2bf(float f) { unsigned u = __builtin_bit_cast(unsigned, f); return (u + 0x7fffu + ((u >> 16) & 1u)) >> 16; }
__device__ __forceinline__ unsigned pk2(float lo, float hi) { return f2bf(lo) | (f2bf(hi) << 16); }
__device__ __forceinline__ float bf2f(unsigned short b) { return __uint_as_float((unsigned)b << 16); }

#define XB_TMO      128
#define XB_XCNT(j)  (256  + 64 * (j))
#define XB_XSUB(j)  (1280 + 64 * (j))
#define XB_XGEN(j)  (2304 + 64 * (j))
#define XB_TOP      3328
#define XB_TOPGEN   3392
#define XCD_BAR_WORDS 3456
#define XB_SPIN_CAP (1u << 22)
__device__ __forceinline__ unsigned xb_ld(unsigned* p)              { return __hip_atomic_load(p, __ATOMIC_RELAXED, __HIP_MEMORY_SCOPE_AGENT); }
__device__ __forceinline__ unsigned xb_add(unsigned* p, unsigned v) { return __hip_atomic_fetch_add(p, v, __ATOMIC_RELAXED, __HIP_MEMORY_SCOPE_AGENT); }
__device__ __forceinline__ unsigned xb_xcc_id() { return (unsigned)__builtin_amdgcn_s_getreg((3 << 11) | 20) & 0xFu; }
#define XB_SPIN(cond, bar) do { unsigned _sp = 0; while (cond) { __builtin_amdgcn_s_sleep(1); \
    if ((++_sp & 255u) == 0u) { if (xb_ld(&(bar)[XB_TMO])) break; if (_sp > XB_SPIN_CAP) { atomicAdd(&(bar)[XB_TMO], 1u); break; } } } } while (0)
struct XcdBarrier { unsigned* bar; unsigned x; volatile LAS unsigned* st; };
__device__ __forceinline__ XcdBarrier xcd_barrier_post(unsigned* bar, volatile LAS unsigned* st) {
    XcdBarrier b; b.bar = bar; b.x = xb_xcc_id(); b.st = st;
    if (threadIdx.x == 0) (void)xb_add(&bar[XB_XCNT(b.x)], 1u);
    return b;
}
__device__ __forceinline__ void xcd_barrier_complete(unsigned* bar, unsigned x, unsigned& nloc, unsigned& nx) {
    const unsigned G = gridDim.x * gridDim.y * gridDim.z;
    unsigned sum, cnt, mine, sp = 0u;
    for (;;) {
        sum = 0u; cnt = 0u; mine = 0u;
#pragma unroll
        for (unsigned j = 0; j < 16; ++j) { const unsigned c = xb_ld(&bar[XB_XCNT(j)]); sum += c; cnt += (c > 0u) ? 1u : 0u; mine = (j == x) ? c : mine; }
        if (sum == G) break;
        __builtin_amdgcn_s_sleep(1);
        if ((++sp & 255u) == 0u) { if (xb_ld(&bar[XB_TMO])) break; if (sp > XB_SPIN_CAP) { atomicAdd(&bar[XB_TMO], 1u); break; } }
    }
    nloc = mine > 0u ? mine : 1u; nx = cnt > 0u ? cnt : 1u;
}
__device__ __forceinline__ void xcd_barrier(const XcdBarrier& b) {
    asm volatile("s_waitcnt vmcnt(0)" ::: "memory");
    __syncthreads();
    if (threadIdx.x == 0) {
        unsigned* bar = b.bar;
        __builtin_amdgcn_s_waitcnt(0);
        unsigned nloc = b.st[0], nx = b.st[1];
        if (nloc == 0u) { xcd_barrier_complete(bar, b.x, nloc, nx); b.st[0] = nloc; b.st[1] = nx; }
        const unsigned old = xb_add(&bar[XB_XSUB(b.x)], 1u);
        const unsigned gen = old / nloc;
        if (old + 1u == (gen + 1u) * nloc) {
            __builtin_amdgcn_fence(__ATOMIC_RELEASE, "agent");
            asm volatile("s_waitcnt vmcnt(0)" ::: "memory");
            const unsigned og = xb_add(&bar[XB_TOP], 1u);
            const unsigned tg = og / nx;
            if (og + 1u == (tg + 1u) * nx) xb_add(&bar[XB_TOPGEN], 1u);
            else XB_SPIN(xb_ld(&bar[XB_TOPGEN]) == tg, bar);
            __builtin_amdgcn_fence(__ATOMIC_ACQUIRE, "agent");
            xb_add(&bar[XB_XGEN(b.x)], 1u);
            asm volatile("s_waitcnt vmcnt(0)" ::: "memory");
        } else {
            XB_SPIN(xb_ld(&bar[XB_XGEN(b.x)]) == gen, bar);
            __builtin_amdgcn_fence(__ATOMIC_ACQUIRE, "agent");
            asm volatile("s_waitcnt vmcnt(0)" ::: "memory");
        }
    }
    __syncthreads();
}

struct GridSync { const XcdBarrier* b; __device__ __forceinline__ void operator()() const { xcd_barrier(*b); } };

struct Args { const float* in[26]; float* out; unsigned char* ws; int ph_lo, ph_hi; };
struct Frame {
    LAS unsigned char* lds; int tid, lane, wave, vcu, G;
};
__device__ __forceinline__ float wave_sum(float v) {
#pragma unroll
    for (int o = 1; o < 64; o <<= 1) v += __shfl_xor(v, o);
    return v;
}
__device__ __forceinline__ float wave_max(float v) {
#pragma unroll
    for (int o = 1; o < 64; o <<= 1) v = fmaxf(v, __shfl_xor(v, o));
    return v;
}

__device__ const unsigned char T5B[128] = {0,1,2,3,4,5,6,7,8,9,10,11,12,13,14,15,16,16,16,17,17,18,18,18,19,19,19,20,20,20,20,21,21,21,21,22,22,22,22,22,23,23,23,23,23,23,24,24,24,24,24,24,25,25,25,25,25,25,25,26,26,26,26,26,26,26,26,27,27,27,27,27,27,27,27,27,27,28,28,28,28,28,28,28,28,28,28,29,29,29,29,29,29,29,29,29,29,29,29,30,30,30,30,30,30,30,30,30,30,30,30,30,30,31,31,31,31,31,31,31,31,31,31,31,31,31,31,31};
__device__ __forceinline__ float gelu_tanh(float x) {
    const float y = 0.7978845608028654f * (x + 0.044715f * x * x * x);
    const float e = __builtin_amdgcn_exp2f(-2.0f * 1.4426950408889634f * fabsf(y));
    const float th = (1.0f - e) * __builtin_amdgcn_rcpf(1.0f + e);
    return 0.5f * x * (1.0f + (y < 0.f ? -th : th));
}
typedef short bf16x8_t __attribute__((ext_vector_type(8)));
typedef float f32x16 __attribute__((ext_vector_type(16)));
typedef unsigned u32x2 __attribute__((ext_vector_type(2)));
constexpr int NSEG = 16, LSEG = SEQ / NSEG;
constexpr int SSMC_STRIDE = 2304;
constexpr int HS_ROWB = 272, HS_BYTES = 32 * HS_ROWB;
constexpr int LDS_HS = 0, LDS_TAB = NWAVES * HS_BYTES, TAB_N = 192;
__device__ __forceinline__ int crow(int r, int hi) { return (r & 3) + 8 * (r >> 2) + 4 * hi; }

__device__ __forceinline__ void ssm_consts_item(const Args& a, int g, int lane) {
    unsigned* tb = (unsigned*)(a.ws + WS_SSMC) + (size_t)g * SSMC_STRIDE;
    const float dt = expf(a.in[11][g]);
    auto disc = [&](int p, float& are, float& aim, float& cre, float& cim) {
        const float lr = fminf(a.in[9][g * 64 + p], -1e-4f), li = a.in[10][g * 64 + p];
        const float mag = expf(lr * dt); are = mag * cosf(li * dt); aim = mag * sinf(li * dt);
        const float den = lr * lr + li * li; cre = ((are - 1.0f) * lr + aim * li) / den; cim = (aim * lr - (are - 1.0f) * li) / den; };
    { float are, aim, cre, cim; disc(lane, are, aim, cre, cim);
      float pr = are, pi = aim;
#pragma unroll
      for (int i = 0; i < 8; ++i) { const float nr = pr * pr - pi * pi, ni = 2.0f * pr * pi; pr = nr; pi = ni; }
      tb[lane] = __float_as_uint(are); tb[64 + lane] = __float_as_uint(aim); tb[128 + lane] = __float_as_uint(pr); tb[192 + lane] = __float_as_uint(pi); }
#pragma unroll
    for (int ph = 0; ph < 2; ++ph) { const int p = 32 * ph + (lane & 31); float are, aim, cre, cim; disc(p, are, aim, cre, cim);
        float bre[8], bim[8];
#pragma unroll
        for (int j = 0; j < 8; ++j) { const int c = 8 * (lane >> 5) + j; const float br = a.in[12][(g * 64 + p) * 16 + c], bi = a.in[13][(g * 64 + p) * 16 + c];
            bre[j] = cre * br - cim * bi; bim[j] = cre * bi + cim * br; }
        unsigned* d0 = tb + 256 + ((0 * 2 + ph) * 64 + lane) * 4; unsigned* d1 = tb + 256 + ((1 * 2 + ph) * 64 + lane) * 4;
#pragma unroll
        for (int j = 0; j < 4; ++j) { d0[j] = pk2(bre[2 * j], bre[2 * j + 1]); d1[j] = pk2(bim[2 * j], bim[2 * j + 1]); } }
#pragma unroll
    for (int ks = 0; ks < 4; ++ks) { const int ch = lane & 15; float cv[8];
#pragma unroll
        for (int j = 0; j < 8; ++j) { const int k = 32 * ks + 8 * (lane >> 4) + j, p = k >> 1; cv[j] = (k & 1) ? -a.in[15][(g * 16 + ch) * 64 + p] : a.in[14][(g * 16 + ch) * 64 + p]; }
        unsigned* d = tb + 256 + 1024 + (ks * 64 + lane) * 4;
#pragma unroll
        for (int j = 0; j < 4; ++j) d[j] = pk2(cv[2 * j], cv[2 * j + 1]); }
}

struct SsmConsts { float are, aim; bf16x8_t BF[4]; };
__device__ __forceinline__ bf16x8_t ssm_load_af(const bf16* U, int row0, int g, int lane) { return *(const bf16x8_t*)(U + (size_t)(row0 + (lane & 31)) * SW + g * 16 + 8 * (lane >> 5)); }
__device__ __forceinline__ void ssm_x_chunk(const bf16x8_t af, const SsmConsts& C, f32x16& xar, f32x16& xbr, f32x16& xai, f32x16& xbi) {
    const f32x16 z = {};
    xar = __builtin_amdgcn_mfma_f32_32x32x16_bf16(af, C.BF[0], z, 0, 0, 0); xbr = __builtin_amdgcn_mfma_f32_32x32x16_bf16(af, C.BF[1], z, 0, 0, 0);
    xai = __builtin_amdgcn_mfma_f32_32x32x16_bf16(af, C.BF[2], z, 0, 0, 0); xbi = __builtin_amdgcn_mfma_f32_32x32x16_bf16(af, C.BF[3], z, 0, 0, 0);
#pragma unroll
    for (int i = 0; i < 16; ++i) {
        auto r = __builtin_amdgcn_permlane32_swap(__float_as_uint(xar[i]), __float_as_uint(xbr[i]), false, false); xar[i] = __uint_as_float(r[0]); xbr[i] = __uint_as_float(r[1]);
        auto q = __builtin_amdgcn_permlane32_swap(__float_as_uint(xai[i]), __float_as_uint(xbi[i]), false, false); xai[i] = __uint_as_float(q[0]); xbi[i] = __uint_as_float(q[1]); }
}
#define SSM_STEP(XR, XI) do { float t1_ = __builtin_fmaf(-C.aim, hi, (XR)), t2_ = __builtin_fmaf(C.aim, hr, (XI)); asm("" : "+v"(t1_)); asm("" : "+v"(t2_)); \
                              float nr_ = __builtin_fmaf(C.are, hr, t1_), ni_ = __builtin_fmaf(C.are, hi, t2_); asm("" : "+v"(nr_)); asm("" : "+v"(ni_)); hr = nr_; hi = ni_; } while (0)
__device__ __forceinline__ void ssm_pass_a(const Args& a, int b, int g, int s, int lane) {
    const bf16* U = (const bf16*)(a.ws + WS_U); const unsigned* tb = (const unsigned*)(a.ws + WS_SSMC) + (size_t)g * SSMC_STRIDE;
    SsmConsts C; C.are = __uint_as_float(tb[lane]); C.aim = __uint_as_float(tb[64 + lane]);
#pragma unroll
    for (int v = 0; v < 4; ++v) C.BF[v] = *(const bf16x8_t*)(tb + 256 + (v * 64 + lane) * 4);
    float hr = 0.f, hi = 0.f;
    bf16x8_t af = ssm_load_af(U, b * SEQ + s * LSEG, g, lane);
    for (int ch = 0; ch < LSEG / 32; ++ch) {
        const bf16x8_t afn = ssm_load_af(U, b * SEQ + s * LSEG + (ch + 1 < LSEG / 32 ? ch + 1 : ch) * 32, g, lane);
        f32x16 xar, xbr, xai, xbi; ssm_x_chunk(af, C, xar, xbr, xai, xbi); af = afn;
#pragma unroll
        for (int j = 0; j < 4; ++j) {
#pragma unroll
            for (int k = 0; k < 4; ++k) SSM_STEP(xar[4 * j + k], xai[4 * j + k]);
#pragma unroll
            for (int k = 0; k < 4; ++k) SSM_STEP(xbr[4 * j + k], xbi[4 * j + k]); }
    }
    float* hl = (float*)(a.ws + WS_HLOC) + ((size_t)(b * 64 + g) * NSEG + s) * 128; hl[lane] = hr; hl[64 + lane] = hi;
}
__device__ __forceinline__ u32x2 ssm_load_uw(const bf16* U, int row0, int tl, int g, int lane) { return *(const GAS u32x2*)(U + (size_t)(row0 + 16 * tl + (lane & 15)) * SW + g * 16 + 4 * (lane >> 4)); }
__device__ __forceinline__ void ssm_y_chunk(const Args& a, int row0, int g, int lane, LAS unsigned char* hs, const bf16x8_t (&CF)[4], const float (&dsk)[4], const u32x2 uw0, const u32x2 uw1) {
    bf16* G = (bf16*)(a.ws + WS_G);
    LDS_WAIT(); asm volatile("" ::: "memory");
#pragma unroll
    for (int tl = 0; tl < 2; ++tl) { f32x4 acc = {0.f, 0.f, 0.f, 0.f};
#pragma unroll
        for (int ks = 0; ks < 4; ++ks) { const bf16x8_t hf = *(const LAS bf16x8_t*)(hs + (16 * tl + (lane & 15)) * HS_ROWB + 64 * ks + 16 * (lane >> 4));
            acc = __builtin_amdgcn_mfma_f32_16x16x32_bf16(CF[ks], hf, acc, 0, 0, 0); }
        const size_t off = (size_t)(row0 + 16 * tl + (lane & 15)) * SW + g * 16 + 4 * (lane >> 4);
        const u32x2 uw = tl == 0 ? uw0 : uw1;
        const float y0 = acc[0] + dsk[0] * __uint_as_float(uw.x << 16), y1 = acc[1] + dsk[1] * __uint_as_float(uw.x & 0xffff0000u);
        const float y2 = acc[2] + dsk[2] * __uint_as_float(uw.y << 16), y3 = acc[3] + dsk[3] * __uint_as_float(uw.y & 0xffff0000u);
        u32x2 o; o.x = pg8::cvt_pk_bf16(gelu_tanh(y0), gelu_tanh(y1)); o.y = pg8::cvt_pk_bf16(gelu_tanh(y2), gelu_tanh(y3));
        *(GAS u32x2*)(G + off) = o; }
    LDS_WAIT(); asm volatile("" ::: "memory");
}
#define SSM_STEP_W(XR, XI, T) do { SSM_STEP(XR, XI); *(LAS unsigned*)(hs + (T) * HS_ROWB + 4 * lane) = pg8::cvt_pk_bf16(hr, hi); } while (0)
__device__ __forceinline__ void ssm_pass_b_prompt(const Args& a, int b, int g, int s, int lane, LAS unsigned char* hs) {
    const bf16* U = (const bf16*)(a.ws + WS_U); const unsigned* tb = (const unsigned*)(a.ws + WS_SSMC) + (size_t)g * SSMC_STRIDE;
    SsmConsts C; C.are = __uint_as_float(tb[lane]); C.aim = __uint_as_float(tb[64 + lane]);
    const float alr = __uint_as_float(tb[128 + lane]), ali = __uint_as_float(tb[192 + lane]);
#pragma unroll
    for (int v = 0; v < 4; ++v) C.BF[v] = *(const bf16x8_t*)(tb + 256 + (v * 64 + lane) * 4);
    bf16x8_t CF[4];
#pragma unroll
    for (int ks = 0; ks < 4; ++ks) CF[ks] = *(const bf16x8_t*)(tb + 256 + 1024 + (ks * 64 + lane) * 4);
    float dsk[4];
#pragma unroll
    for (int r = 0; r < 4; ++r) dsk[r] = a.in[16][g * 16 + 4 * (lane >> 4) + r];
    float hr = 0.f, hi = 0.f;
    const float* hl = (const float*)(a.ws + WS_HLOC) + (size_t)(b * 64 + g) * NSEG * 128;
    { float lre[NSEG - 1], lim[NSEG - 1];
#pragma unroll
      for (int sp = 0; sp < NSEG - 1; ++sp) { const bool on = sp < s; lre[sp] = on ? hl[sp * 128 + lane] : 0.f; lim[sp] = on ? hl[sp * 128 + 64 + lane] : 0.f; }
#pragma unroll
      for (int sp = 0; sp < NSEG - 1; ++sp) if (sp < s) { const float nr = alr * hr - ali * hi + lre[sp], ni = alr * hi + ali * hr + lim[sp]; hr = nr; hi = ni; } }
    bf16x8_t af = ssm_load_af(U, b * SEQ + s * LSEG, g, lane);
    for (int ch = 0; ch < LSEG / 32; ++ch) {
        const int row0 = b * SEQ + s * LSEG + ch * 32;
        const bf16x8_t afn = ssm_load_af(U, row0 + (ch + 1 < LSEG / 32 ? 32 : 0), g, lane);
        const u32x2 uw0 = ssm_load_uw(U, row0, 0, g, lane), uw1 = ssm_load_uw(U, row0, 1, g, lane);
        f32x16 xar, xbr, xai, xbi; ssm_x_chunk(af, C, xar, xbr, xai, xbi); af = afn;
#pragma unroll
        for (int j = 0; j < 4; ++j) {
#pragma unroll
            for (int k = 0; k < 4; ++k) SSM_STEP_W(xar[4 * j + k], xai[4 * j + k], 8 * j + k);
#pragma unroll
            for (int k = 0; k < 4; ++k) SSM_STEP_W(xbr[4 * j + k], xbi[4 * j + k], 8 * j + 4 + k); }
        ssm_y_chunk(a, row0, g, lane, hs, CF, dsk, uw0, uw1);
    }
    if (s == NSEG - 1) { a.out[O_PRE + (size_t)(b * 64 + g) * 64 + lane] = hr; a.out[O_PIM + (size_t)(b * 64 + g) * 64 + lane] = hi; }
}
__device__ __forceinline__ void ssm_sample_item(const Args& a, int n8, int g, int lane, LAS unsigned char* hs) {
    const bf16* U = (const bf16*)(a.ws + WS_U); const unsigned* tb = (const unsigned*)(a.ws + WS_SSMC) + (size_t)g * SSMC_STRIDE;
    SsmConsts C; C.are = __uint_as_float(tb[lane]); C.aim = __uint_as_float(tb[64 + lane]);
#pragma unroll
    for (int v = 0; v < 4; ++v) C.BF[v] = *(const bf16x8_t*)(tb + 256 + (v * 64 + lane) * 4);
    bf16x8_t CF[4];
#pragma unroll
    for (int ks = 0; ks < 4; ++ks) CF[ks] = *(const bf16x8_t*)(tb + 256 + 1024 + (ks * 64 + lane) * 4);
    float dsk[4];
#pragma unroll
    for (int r = 0; r < 4; ++r) dsk[r] = a.in[16][g * 16 + 4 * (lane >> 4) + r];
    const int row0 = MP + n8 * 32;
    const u32x2 uw0 = ssm_load_uw(U, row0, 0, g, lane), uw1 = ssm_load_uw(U, row0, 1, g, lane);
    f32x16 xar, xbr, xai, xbi; ssm_x_chunk(ssm_load_af(U, row0, g, lane), C, xar, xbr, xai, xbi);
    float h0r[8], h0i[8];
#pragma unroll
    for (int q = 0; q < 8; ++q) { const size_t si = (size_t)((n8 * 8 + q) * 64 + g) * 64 + lane; h0r[q] = a.in[2][si]; h0i[q] = a.in[3][si]; }
#pragma unroll
    for (int j = 0; j < 4; ++j) {
        { float hr = h0r[2 * j], hi = h0i[2 * j];
#pragma unroll
          for (int k = 0; k < 4; ++k) SSM_STEP_W(xar[4 * j + k], xai[4 * j + k], 8 * j + k);
          const size_t so = (size_t)((n8 * 8 + 2 * j) * 64 + g) * 64 + lane; a.out[O_SRE + so] = hr; a.out[O_SIM + so] = hi; }
        { float hr = h0r[2 * j + 1], hi = h0i[2 * j + 1];
#pragma unroll
          for (int k = 0; k < 4; ++k) SSM_STEP_W(xbr[4 * j + k], xbi[4 * j + k], 8 * j + 4 + k);
          const size_t so = (size_t)((n8 * 8 + 2 * j + 1) * 64 + g) * 64 + lane; a.out[O_SRE + so] = hr; a.out[O_SIM + so] = hi; }
    }
    ssm_y_chunk(a, row0, g, lane, hs, CF, dsk, uw0, uw1);
}

__device__ __forceinline__ void attn_prompt_item(const Args& a, int b, int h, int qt, int lane, const LAS float* tab) {
    const bf16* Q = (const bf16*)(a.ws + WS_Q); const bf16* KB = (const bf16*)(a.ws + WS_KB); const bf16* VT = (const bf16*)(a.ws + WS_VT); bf16* O = (bf16*)(a.ws + WS_O);
    const int kvh = h >> 2, lq = lane & 31, hh = lane >> 5, t0 = 32 * qt;
    const size_t rowq = (size_t)b * SEQ + t0 + lq;
    bf16x8_t qf[4];
#pragma unroll
    for (int ks = 0; ks < 4; ++ks) qf[ks] = *(const bf16x8_t*)(Q + rowq * SW + h * 64 + 16 * ks + 8 * hh);
    f32x16 S[5]; float mx = -1e30f;
    const LAS float* th = tab + h * TAB_N;
    bf16x8_t kf[5][4];
#pragma unroll
    for (int i = 0; i < 5; ++i) { const int ktile = qt - 4 + i; const int kt0 = 32 * (ktile >= 0 ? ktile : 0);
        const bf16* kp = KB + ((size_t)((b * 4 + kvh) * (SEQ / 32) + (kt0 >> 5))) * 2048 + lane * 8;
#pragma unroll
        for (int ks = 0; ks < 4; ++ks) kf[i][ks] = *(const bf16x8_t*)(kp + 512 * ks); }
#pragma unroll
    for (int i = 0; i < 5; ++i) {
        const int ktile = qt - 4 + i; const bool tv = ktile >= 0; const int kt0 = 32 * (tv ? ktile : 0);
        f32x16 acc = {};
#pragma unroll
        for (int ks = 0; ks < 4; ++ks) acc = __builtin_amdgcn_mfma_f32_32x32x16_bf16(kf[i][ks], qf[ks], acc, 0, 0, 0);
        const int dbase = (t0 - kt0) + lq - 4 * hh + 32;
#pragma unroll
        for (int r = 0; r < 16; ++r) { const float bv = tv ? th[dbase - (r & 3) - 8 * (r >> 2)] : -1e30f; acc[r] += bv; mx = fmaxf(mx, acc[r]); }
        S[i] = acc;
    }
    bf16x8_t vfr[5][2][2];
#pragma unroll
    for (int i = 0; i < 5; ++i) { const int ktile = qt - 4 + i; const int kt0 = 32 * (ktile >= 0 ? ktile : 0);
        const bf16* vp = VT + ((size_t)((b * 4 + kvh) * (SEQ / 32) + (kt0 >> 5))) * 2048 + lane * 8;
#pragma unroll
        for (int s2 = 0; s2 < 2; ++s2)
#pragma unroll
            for (int db = 0; db < 2; ++db) vfr[i][s2][db] = *(const bf16x8_t*)(vp + (s2 * 2 + db) * 512); }
    { auto rr = __builtin_amdgcn_permlane32_swap(__float_as_uint(mx), __float_as_uint(mx), false, false); mx = fmaxf(__uint_as_float(rr[0]), __uint_as_float(rr[1])); }
    const float sink = a.in[20][h]; mx = fmaxf(mx, sink);
    const float L2E = 1.4426950408889634f, mb = -mx * L2E; float sum = 0.f;
#pragma unroll
    for (int i = 0; i < 5; ++i)
#pragma unroll
        for (int r = 0; r < 16; ++r) { const float p = __builtin_amdgcn_exp2f(S[i][r] * L2E + mb); S[i][r] = p; sum += p; }
    { auto rr = __builtin_amdgcn_permlane32_swap(__float_as_uint(sum), __float_as_uint(sum), false, false); sum = __uint_as_float(rr[0]) + __uint_as_float(rr[1]); }
    const float inv = 1.0f / (sum + __builtin_amdgcn_exp2f(sink * L2E + mb));
    f32x16 o0 = {}, o1 = {};
#pragma unroll
    for (int i = 0; i < 5; ++i) {
#pragma unroll
        for (int s2 = 0; s2 < 2; ++s2) {
            pg8::u32x4 pw; pw.x = pg8::cvt_pk_bf16(S[i][8 * s2 + 0], S[i][8 * s2 + 1]); pw.y = pg8::cvt_pk_bf16(S[i][8 * s2 + 2], S[i][8 * s2 + 3]);
            pw.z = pg8::cvt_pk_bf16(S[i][8 * s2 + 4], S[i][8 * s2 + 5]); pw.w = pg8::cvt_pk_bf16(S[i][8 * s2 + 6], S[i][8 * s2 + 7]);
            const bf16x8_t pf = __builtin_bit_cast(bf16x8_t, pw);
#pragma unroll
            for (int db = 0; db < 2; ++db) {
                const bf16x8_t vf = vfr[i][s2][db];
                if (db == 0) o0 = __builtin_amdgcn_mfma_f32_32x32x16_bf16(vf, pf, o0, 0, 0, 0); else o1 = __builtin_amdgcn_mfma_f32_32x32x16_bf16(vf, pf, o1, 0, 0, 0);
            } } }
    bf16* op = O + rowq * SW + h * 64 + 4 * hh;
#pragma unroll
    for (int gq = 0; gq < 4; ++gq) {
        u32x2 w0; w0.x = pg8::cvt_pk_bf16(o0[4 * gq] * inv, o0[4 * gq + 1] * inv); w0.y = pg8::cvt_pk_bf16(o0[4 * gq + 2] * inv, o0[4 * gq + 3] * inv);
        u32x2 w1; w1.x = pg8::cvt_pk_bf16(o1[4 * gq] * inv, o1[4 * gq + 1] * inv); w1.y = pg8::cvt_pk_bf16(o1[4 * gq + 2] * inv, o1[4 * gq + 3] * inv);
        *(GAS u32x2*)(op + 8 * gq) = w0; *(GAS u32x2*)(op + 32 + 8 * gq) = w1; }
}
__device__ __forceinline__ void attn_sample_item(const Args& a, int n, int h, int lane_in, const LAS float* tab, LAS unsigned char* ws_l) {
    int lane = lane_in; asm volatile("" : "+v"(lane));
    const bf16* Q = (const bf16*)(a.ws + WS_Q); const float* KF = (const float*)(a.ws + WS_KF); const float* VF = (const float*)(a.ws + WS_VF); bf16* O = (bf16*)(a.ws + WS_O);
    const int kvh = h >> 2; const size_t row0 = (size_t)MP + n * 4;
    LAS float* ps = (LAS float*)ws_l;
    const LAS float* th = tab + h * TAB_N;
    { const int k4 = lane >> 4, c = lane & 15;
      f32x4 qv[4];
#pragma unroll
      for (int i = 0; i < 4; ++i) { const u32x2 w = *(const GAS u32x2*)(Q + (row0 + i) * SW + h * 64 + 4 * c);
          qv[i] = (f32x4){__uint_as_float(w.x << 16), __uint_as_float(w.x & 0xffff0000u), __uint_as_float(w.y << 16), __uint_as_float(w.y & 0xffff0000u)}; }
#define ROWSUM(x) do { x += __builtin_bit_cast(float, __builtin_amdgcn_mov_dpp(__builtin_bit_cast(int, x), 0x128, 0xf, 0xf, false)); x += __builtin_bit_cast(float, __builtin_amdgcn_mov_dpp(__builtin_bit_cast(int, x), 0x124, 0xf, 0xf, false)); \
                       x += __builtin_bit_cast(float, __builtin_amdgcn_mov_dpp(__builtin_bit_cast(int, x), 0x122, 0xf, 0xf, false)); x += __builtin_bit_cast(float, __builtin_amdgcn_mov_dpp(__builtin_bit_cast(int, x), 0x121, 0xf, 0xf, false)); } while (0)
#pragma unroll
      for (int bt = 0; bt < 3; ++bt) {
          f32x4 kq[11];
#pragma unroll
          for (int u = 0; u < 11; ++u) { const int key = 4 * (bt * 11 + u) + k4;
              const float* kp = (key >= 128) ? KF + (row0 + (key - 128)) * KVW + kvh * 64 : a.in[4] + ((size_t)(n * 128 + key) * 4 + kvh) * 64;
              kq[u] = *(const GAS f32x4*)(kp + 4 * c); }
#pragma unroll
          for (int u = 0; u < 11; ++u) { const int key = 4 * (bt * 11 + u) + k4; const f32x4 kv = kq[u];
              float s0 = qv[0].x * kv.x + qv[0].y * kv.y + qv[0].z * kv.z + qv[0].w * kv.w, s1 = qv[1].x * kv.x + qv[1].y * kv.y + qv[1].z * kv.z + qv[1].w * kv.w;
              float s2 = qv[2].x * kv.x + qv[2].y * kv.y + qv[2].z * kv.z + qv[2].w * kv.w, s3 = qv[3].x * kv.x + qv[3].y * kv.y + qv[3].z * kv.z + qv[3].w * kv.w;
              ROWSUM(s0); ROWSUM(s1); ROWSUM(s2); ROWSUM(s3);
              const int ib = 160 - key;
              if (c == 0) *(LAS f32x4*)(ps + 4 * key) = (f32x4){s0 + th[ib], s1 + th[ib + 1], s2 + th[ib + 2], s3 + th[ib + 3]}; }
          asm volatile("" ::: "memory");
      }
#undef ROWSUM
    }
    LDS_WAIT(); asm volatile("" ::: "memory");
    const f32x4 NEG4 = {-1e30f, -1e30f, -1e30f, -1e30f};
    f32x4 sA = *(const LAS f32x4*)(ps + 4 * lane), sB = *(const LAS f32x4*)(ps + 4 * (64 + lane)), sC = (lane < 4) ? *(const LAS f32x4*)(ps + 4 * (128 + (lane & 3))) : NEG4;
    LDS_WAIT(); asm volatile("" ::: "memory");
    const float sink = a.in[20][h], L2E = 1.4426950408889634f;
    f32x4 inv;
#pragma unroll
    for (int i = 0; i < 4; ++i) {
        const float mx = fmaxf(wave_max(fmaxf(fmaxf(sA[i], sB[i]), sC[i])), sink), mb = -mx * L2E;
        const float e0 = __builtin_amdgcn_exp2f(sA[i] * L2E + mb), e1 = __builtin_amdgcn_exp2f(sB[i] * L2E + mb), e2 = __builtin_amdgcn_exp2f(sC[i] * L2E + mb);
        sA[i] = e0; sB[i] = e1; sC[i] = e2;
        inv[i] = 1.0f / (wave_sum(e0 + e1 + e2) + __builtin_amdgcn_exp2f(sink * L2E + mb));
    }
    *(LAS f32x4*)(ps + 4 * lane) = sA * inv; *(LAS f32x4*)(ps + 4 * (64 + lane)) = sB * inv; if (lane < 8) *(LAS f32x4*)(ps + 4 * (128 + lane)) = sC * inv;
    LDS_WAIT(); asm volatile("" ::: "memory");
    float o0 = 0.f, o1 = 0.f, o2 = 0.f, o3 = 0.f;
    const float* vc = a.in[5] + ((size_t)(n * 128) * 4 + kvh) * 64 + lane;
#pragma unroll 32
    for (int j = 0; j < 128; ++j) { const float v = vc[(size_t)j * 256];   const f32x4 p = *(const LAS f32x4*)(ps + 4 * j); o0 += p.x * v; o1 += p.y * v; o2 += p.z * v; o3 += p.w * v; }
#pragma unroll
    for (int j = 128; j < 132; ++j) { const float v = VF[(row0 + (j - 128)) * KVW + kvh * 64 + lane]; const f32x4 p = *(const LAS f32x4*)(ps + 4 * j); o0 += p.x * v; o1 += p.y * v; o2 += p.z * v; o3 += p.w * v; }
    O[(row0 + 0) * SW + h * 64 + lane] = (bf16)f2bf(o0); O[(row0 + 1) * SW + h * 64 + lane] = (bf16)f2bf(o1);
    O[(row0 + 2) * SW + h * 64 + lane] = (bf16)f2bf(o2); O[(row0 + 3) * SW + h * 64 + lane] = (bf16)f2bf(o3);
    LDS_WAIT(); asm volatile("" ::: "memory");
}
#ifndef DUP_SUB
#define DUP_SUB 0
#endif
__device__ __forceinline__ void p2a_phase(const Frame& F, const Args& a) {
    unsigned char* ws = a.ws;
    const int gw = F.vcu * NWAVES + F.wave, NGW = F.G * NWAVES;
    LAS float* tab = (LAS float*)(F.lds + LDS_TAB);
    for (int i = F.tid; i < NH * TAB_N; i += NWAVES * 64) { const int h = i / TAB_N, dist = i % TAB_N - 32; tab[i] = (dist >= 0 && dist < WIN) ? a.in[6][T5B[dist] * 16 + h] : -1e30f; }
    __syncthreads();
    for (int rp_ = 0; rp_ < (DUP_SUB == 1 ? 2 : 1); ++rp_)
    for (int it = gw; it < 2 * NGRP * (NSEG - 1); it += NGW) { const int bg = it / (NSEG - 1), sgm = it % (NSEG - 1); ssm_pass_a(a, bg / NGRP, bg % NGRP, sgm, F.lane); }
    for (int rp_ = 0; rp_ < (DUP_SUB == 2 ? 2 : 1); ++rp_)
    for (int it = gw; it < 2 * NH * (SEQ / 32); it += NGW) attn_prompt_item(a, it / (NH * (SEQ / 32)), (it / (SEQ / 32)) % NH, it % (SEQ / 32), F.lane, tab);
    { LAS unsigned char* wsl = F.lds + LDS_HS + F.wave * HS_BYTES;
      for (int rp_ = 0; rp_ < (DUP_SUB == 3 ? 2 : 1); ++rp_)
      for (int it = gw; it < DECB * NH; it += NGW) attn_sample_item(a, it / NH, it % NH, F.lane, tab, wsl); }
    const float* KF = (const float*)(ws + WS_KF); const float* VF = (const float*)(ws + WS_VF);
    for (int rp_ = 0; rp_ < (DUP_SUB == 4 ? 2 : 1); ++rp_)
    for (int r0 = gw; r0 < (DECB + 2) * 128 * 2; r0 += 4 * NGW) {
        f32x4 val[4]; float* dst[4];
#pragma unroll
        for (int u = 0; u < 4; ++u) { int rr = r0 + u * NGW; if (rr >= (DECB + 2) * 128 * 2) rr = r0;
            const int kv = rr & 1, row = rr >> 1, n = row >> 7, j = row & 127; const float* src;
            if (n < DECB) { src = (j < 124) ? a.in[4 + kv] + (size_t)(n * 128 + j + 4) * 256 : (kv ? VF : KF) + (size_t)(MP + n * 4 + (j - 124)) * KVW; dst[u] = a.out + (kv ? O_SV : O_SK) + (size_t)row * 256; }
            else { const int b = n - DECB; src = (kv ? VF : KF) + (size_t)(b * SEQ + SEQ - 128 + j) * KVW; dst[u] = a.out + (kv ? O_PV : O_PK) + (size_t)(b * 128 + j) * 256; }
            val[u] = *(const GAS f32x4*)(src + 4 * F.lane); }
#pragma unroll
        for (int u = 0; u < 4; ++u) *(GAS f32x4*)(dst[u] + 4 * F.lane) = val[u];
    }
}
__device__ __forceinline__ void p2b_phase(const Frame& F, const Args& a) {
    const int gw = F.vcu * NWAVES + F.wave, NGW = F.G * NWAVES;
    LAS unsigned char* hs = F.lds + LDS_HS + F.wave * HS_BYTES;
    for (int it = gw; it < 2 * NGRP * NSEG; it += NGW) { const int bg = it / NSEG, sgm = it % NSEG; ssm_pass_b_prompt(a, bg / NGRP, bg % NGRP, sgm, F.lane, hs); }
    for (int it = gw; it < (DECB / 8) * NGRP; it += NGW) ssm_sample_item(a, it / NGRP, it % NGRP, F.lane, hs);
}
struct P0Item { const float* W; const float* ksc; bf16* WT; int K, N, k0, n0, drow0; };
template <bool NT = false> __device__ __forceinline__ void p0_load(const P0Item& d, f32x4 (&v)[16], int lane) {
    const int r = lane >> 4, c = lane & 15;
#pragma unroll
    for (int j = 0; j < 16; ++j) { const int k = d.k0 + 8 * (j >> 1) + 2 * r + (j & 1); const GAS f32x4* p = (const GAS f32x4*)(d.W + (size_t)k * d.N + d.n0 + 4 * c); v[j] = NT ? __builtin_nontemporal_load(p) : *p; }
}
template <bool NT = false> __device__ __forceinline__ void p0_finish(const P0Item& d, f32x4 (&v)[16], LAS unsigned* scr, int lane) {
    const int r = lane >> 4, c = lane & 15;
    if (d.ksc) {
#pragma unroll
        for (int j = 0; j < 16; ++j) v[j] = v[j] * d.ksc[d.k0 + 8 * (j >> 1) + 2 * r + (j & 1)]; }
#pragma unroll
    for (int m = 0; m < 8; ++m)
#pragma unroll
        for (int e = 0; e < 4; ++e) { const int n = 4 * c + e; scr[n * 36 + 4 * (m ^ ((n >> 3) & 7)) + r] = pg8::cvt_pk_bf16(v[2 * m][e], v[2 * m + 1][e]); }
    LDS_WAIT(); asm volatile("" ::: "memory");
    const int q = lane & 7;
#pragma unroll
    for (int i = 0; i < 8; ++i) { const int nn = (lane >> 3) + 8 * i; const v4u w = *(const LAS v4u*)(scr + nn * 36 + 4 * (q ^ ((nn >> 3) & 7)));
        GAS v4u* po = (GAS v4u*)(d.WT + (size_t)(d.drow0 + nn) * d.K + d.k0 + 8 * q); if (NT) __builtin_nontemporal_store(w, po); else *po = w; }
    LDS_WAIT(); asm volatile("" ::: "memory");
}
__device__ __forceinline__ void p0_transpose_item(const float* W, int K, int N, const float* ksc, bf16* WT, int k0, int n0, int drow0, LAS unsigned* scr, int lane) {
    const P0Item d{W, ksc, WT, K, N, k0, n0, drow0}; f32x4 v[16]; p0_load(d, v, lane); p0_finish(d, v, scr, lane);
}
__device__ __forceinline__ int il_row(int j, int h) { return (j >> 7) * 256 + h * 128 + (j & 127); }

constexpr int I_IN_ITEMS = (D / 64) * (NIN / 64), I_GV_ITEMS = (SW / 64) * (D / 64), I_OUT_ITEMS = (D / 64) * (D / 64), I_FI_ITEMS = (D / 64) * (2 * FF / 64), I_FO_ITEMS = (FF / 64) * (D / 64);
constexpr int I_MID_ITEMS = 3 * I_GV_ITEMS + I_OUT_ITEMS + I_FI_ITEMS, N_ITEMS = I_IN_ITEMS + I_MID_ITEMS + I_FO_ITEMS;
__device__ __forceinline__ int ffo_late_idle(int G) { pg8::StaticOrder S; S.init(M, 2 * FF, D, G, 0, 8); const int idle = (S.T.r == 0) ? S.T.R * G - S.nwg : 0; return idle >= 32 ? idle : 0; }
#ifndef P1_NG
#define P1_NG 224
#endif
#ifndef CONV1
#define CONV1 8192
#endif
__device__ __forceinline__ int p1_gemm_wgs(int G) { return (G == 256) ? P1_NG : G; }
__device__ __forceinline__ int p1_conv_items(int G) { return (p1_gemm_wgs(G) < G) ? (CONV1 < I_MID_ITEMS ? CONV1 : I_MID_ITEMS) : 0; }
__device__ __forceinline__ void p0_item(const Args& a, int it, LAS unsigned* scr, int lane) {
    unsigned char* ws = a.ws; constexpr int I_IN = I_IN_ITEMS, I_GV = I_GV_ITEMS, I_OUT = I_OUT_ITEMS, I_FI = I_FI_ITEMS;
    int r = it;
    if (r < I_IN) { const int nb = NIN / 64, kb = r / nb, n0 = 64 * (r % nb); p0_transpose_item(a.in[8], D, NIN, a.in[7], (bf16*)(ws + WS_WIN), 64 * kb, n0, n0, scr, lane); return; } r -= I_IN;
    if (r < I_GV) { const int nb = D / 64, kb = r / nb, n0 = 64 * (r % nb); p0_transpose_item(a.in[17], SW, D, nullptr, (bf16*)(ws + WS_WGB), 64 * kb, n0, il_row(n0, 0), scr, lane); return; } r -= I_GV;
    if (r < I_GV) { const int nb = D / 64, kb = r / nb, n0 = 64 * (r % nb); p0_transpose_item(a.in[18], SW, D, nullptr, (bf16*)(ws + WS_WGB), 64 * kb, n0, il_row(n0, 1), scr, lane); return; } r -= I_GV;
    if (r < I_GV) { const int nb = D / 64, kb = r / nb, n0 = 64 * (r % nb); p0_transpose_item(a.in[19], SW, D, nullptr, (bf16*)(ws + WS_WGB), 64 * kb, n0, 4096 + n0, scr, lane); return; } r -= I_GV;
    if (r < I_OUT) { const int nb = D / 64, kb = r / nb, n0 = 64 * (r % nb); p0_transpose_item(a.in[21], D, D, nullptr, (bf16*)(ws + WS_WOUT), 64 * kb, n0, n0, scr, lane); return; } r -= I_OUT;
    if (r < I_FI) { const int nb = 2 * FF / 64, kb = r / nb, n0 = 64 * (r % nb); const int dr = (n0 < FF) ? il_row(n0, 0) : il_row(n0 - FF, 1);
        p0_transpose_item(a.in[23], D, 2 * FF, a.in[22], (bf16*)(ws + WS_WFI), 64 * kb, n0, dr, scr, lane); return; } r -= I_FI;
    { const int nb = D / 64, kb = r / nb, n0 = 64 * (r % nb); p0_transpose_item(a.in[24], FF, D, nullptr, (bf16*)(ws + WS_WFO), 64 * kb, n0, n0, scr, lane); }
}
__device__ __forceinline__ void p0_prologue(const Frame& F, const Args& a) {
    unsigned char* ws = a.ws;
    LAS unsigned* scr = (LAS unsigned*)(F.lds + RING_OFF + F.wave * 16384);
    const int gw = F.vcu * NWAVES + F.wave, NGW = F.G * NWAVES;
    if (gw < NGRP) ssm_consts_item(a, gw, F.lane);
    const int cv = p1_conv_items(F.G), folate = ffo_late_idle(F.G) ? I_FO_ITEMS : 0;
    const int nmid = I_MID_ITEMS - cv, n0 = I_IN_ITEMS + nmid + (I_FO_ITEMS - folate);
    for (int j = gw; j < n0; j += NGW) p0_item(a, j < I_IN_ITEMS ? j : (j < I_IN_ITEMS + nmid ? j + cv : j + cv + folate), scr, F.lane);
    bf16* XB = (bf16*)(ws + WS_XB); float* rs1 = (float*)(ws + WS_RS1);
    for (int m0 = F.vcu * 32 + F.wave * 4; m0 < M; m0 += F.G * 32) for (int m = m0; m < m0 + 4; ++m) {
        const float* xrow = (m < MP) ? a.in[0] + (size_t)m * D : a.in[1] + (size_t)(m - MP) * D;
        const GAS f32x4* xr = (const GAS f32x4*)xrow + F.lane;
        f32x4 v[8]; float s = 0.f;
#pragma unroll
        for (int j = 0; j < 8; ++j) { v[j] = xr[64 * j]; s += (v[j].x * v[j].x + v[j].y * v[j].y) + (v[j].z * v[j].z + v[j].w * v[j].w); }
        s = wave_sum(s);
        GAS unsigned long long* o8 = (GAS unsigned long long*)(XB + (size_t)m * D) + F.lane;
#pragma unroll
        for (int j = 0; j < 8; ++j) o8[64 * j] = (unsigned long long)pk2(v[j].x, v[j].y) | ((unsigned long long)pk2(v[j].z, v[j].w) << 32);
        if (F.lane == 0) rs1[m] = 1.0f / sqrtf(s * (1.0f / D) + EPS);
    }
}

__device__ __forceinline__ void p7_phase(const Frame& F, const Args& a) {
    const int gw = F.vcu * NWAVES + F.wave, NGW = F.G * NWAVES;
    const float* RSS = (const float*)(a.ws + WS_RSS3); const float* gf = a.in[25]; const bf16* X2 = (const bf16*)(a.ws + WS_D);
    for (int m = gw; m < M; m += NGW) {
        const float pv = (F.lane < 32) ? RSS[((size_t)(F.lane >> 2) * M + m) * 4 + (F.lane & 3)] : 0.f;
        const GAS v4u* xr = (const GAS v4u*)(X2 + (size_t)m * D) + F.lane; v4u w[4];
#pragma unroll
        for (int j = 0; j < 4; ++j) w[j] = xr[64 * j];
        const float s = 1.0f / sqrtf(wave_sum(pv) * (1.0f / D) + EPS);
        GAS f32x4* yr = (GAS f32x4*)(a.out + (size_t)m * D); const GAS f32x4* gr = (const GAS f32x4*)gf;
#pragma unroll
        for (int j = 0; j < 4; ++j) { const int c4 = 2 * (64 * j + F.lane); pg8::f32x4 v0, v1; pg8::unpack8(__builtin_bit_cast(pg8::u32x4, w[j]), v0, v1);
            yr[c4] = v0 * s * gr[c4]; yr[c4 + 1] = v1 * s * gr[c4 + 1]; }
    }
}

#ifndef DBG_STOP
#define DBG_STOP 0
#endif
__device__ __forceinline__ void dbg_dump_bf16(const Frame& F, const Args& a, const bf16* src, int ld, int c0, int n) {
    const int gt = (F.vcu * NWAVES + F.wave) * 64 + F.lane, NGT = F.G * NWAVES * 64;
    for (size_t i = gt; i < (size_t)M * n; i += NGT) { const size_t r = i / n, j = i % n; a.out[r * D + c0 + j] = bf2f(src[r * ld + j]); }
}
__global__ void __launch_bounds__(NWAVES * 64, 2) mega_fwd(Args args) {
    extern __shared__ __attribute__((aligned(16))) unsigned char lds[];
    Frame F;
    F.lds = (LAS unsigned char*)lds;
    volatile LAS unsigned* MISC = (volatile LAS unsigned*)(F.lds + MISC_OFF);
    F.tid = threadIdx.x; F.lane = F.tid & 63; F.wave = __builtin_amdgcn_readfirstlane(F.tid >> 6);
    F.G = gridDim.x; { const int bx = blockIdx.x; F.vcu = (F.G % 8 == 0) ? (bx % 8) * (F.G / 8) + bx / 8 : bx; }
    unsigned char* ws = args.ws;
    gu32* ctl = (gu32*)(ws + WS_CTL);
    for (int u = F.tid; u < (LDS_BYTES - LDSCTL_OFF) / 4; u += NWAVES * 64) ((LAS unsigned*)(F.lds + LDSCTL_OFF))[u] = 0u;
    __syncthreads();
    const int lo = args.ph_lo, hi = args.ph_hi;
    const bool multi = (hi - lo) > 1;
    XcdBarrier bar; bar.bar = (unsigned*)(ctl + CW_BAR); bar.x = 0; bar.st = nullptr;
    if (multi) bar = xcd_barrier_post((unsigned*)(ctl + CW_BAR), MISC + 8);
#define IN(k) (lo <= (k) && (k) < hi)
#define SEAM(k) do { if (IN(k) && IN((k) + 1)) xcd_barrier(bar); } while (0)
    using namespace pg8;
#ifndef DUP_PHASE
#define DUP_PHASE -1
#endif
#define PH_BEGIN(k) if (IN(k)) { for (int rep_ = 0; rep_ < ((DUP_PHASE == (k)) ? 2 : 1); ++rep_) { if (rep_) xcd_barrier(bar);
#define PH_END(k) } SEAM(k); }
    PH_BEGIN(0) p0_prologue(F, args); PH_END(0)
    PH_BEGIN(1)
        const int ng1 = p1_gemm_wgs(F.G);
        if ((int)blockIdx.x >= ng1) {
            LAS unsigned* scr = (LAS unsigned*)(F.lds + RING_OFF + F.wave * 16384); const int cv = p1_conv_items(F.G), ncw = (F.G - ng1) * NWAVES;
            const float* w_gv0 = args.in[17]; const float* w_gv1 = args.in[18]; const float* w_gv2 = args.in[19]; const float* w_out = args.in[21]; const float* w_fi = args.in[23]; const float* k_fi = args.in[22];
            asm volatile("" : "+s"(w_gv0), "+s"(w_gv1), "+s"(w_gv2), "+s"(w_out), "+s"(w_fi), "+s"(k_fi));
            auto mid_item = [&](int k) -> P0Item {
                int r = k, sec, nb;
                if (r < I_GV_ITEMS) { sec = 1; nb = D / 64; } else { r -= I_GV_ITEMS;
                if (r < I_GV_ITEMS) { sec = 2; nb = D / 64; } else { r -= I_GV_ITEMS;
                if (r < I_GV_ITEMS) { sec = 3; nb = D / 64; } else { r -= I_GV_ITEMS;
                if (r < I_OUT_ITEMS) { sec = 4; nb = D / 64; } else { r -= I_OUT_ITEMS; sec = 5; nb = 2 * FF / 64; } } } }
                int kb = r / nb, n0 = 64 * (r - kb * nb);
                sec = __builtin_amdgcn_readfirstlane(sec); kb = __builtin_amdgcn_readfirstlane(kb); n0 = __builtin_amdgcn_readfirstlane(n0);
                P0Item d; d.k0 = 64 * kb; d.n0 = n0;
                d.W = sec == 1 ? w_gv0 : sec == 2 ? w_gv1 : sec == 3 ? w_gv2 : sec == 4 ? w_out : w_fi;
                d.ksc = sec == 5 ? k_fi : nullptr;
                d.WT = (bf16*)(ws + (sec <= 3 ? WS_WGB : sec == 4 ? WS_WOUT : WS_WFI));
                d.K = sec <= 3 ? SW : D; d.N = sec == 5 ? 2 * FF : D;
                d.drow0 = sec == 1 ? il_row(n0, 0) : sec == 2 ? il_row(n0, 1) : sec == 3 ? 4096 + n0 : sec == 4 ? n0 : ((n0 < FF) ? il_row(n0, 0) : il_row(n0 - FF, 1));
                return d; };
            f32x4 va[16], vb[16]; P0Item d0, d1;
            int k = ((int)blockIdx.x - ng1) * NWAVES + F.wave; bool h0 = k < cv;
            if (h0) { d0 = mid_item(k); p0_load<true>(d0, va, F.lane); }
            while (h0) {
                const int k1 = k + ncw; const bool h1 = k1 < cv;
                if (h1) { d1 = mid_item(k1); p0_load<true>(d1, vb, F.lane); }
                p0_finish<true>(d0, va, scr, F.lane);
                if (!h1) break;
                k = k1 + ncw; h0 = k < cv;
                if (h0) { d0 = mid_item(k); p0_load<true>(d0, va, F.lane); }
                p0_finish<true>(d1, vb, scr, F.lane);
            }
        } else {
        Gemm g{(const bf16_t*)(ws + WS_XB), (const bf16_t*)(ws + WS_WIN), D}; StaticOrder S; S.init(M, NIN, D, ng1, (int)blockIdx.x, 8); const TailFix tf{(unsigned char*)args.out, (unsigned*)(ctl + CW_TAIL + 0 * 8192)};
        LAS float* rs1l = (LAS float*)(F.lds + RS2L_OFF);
        { const float* rs1g = (const float*)(ws + WS_RS1); Unit uu;
          float rv[8]; bool on[8];
#pragma unroll
          for (int ui = 0; ui < 8; ++ui) { on[ui] = S.next(ui, uu); rv[ui] = rs1g[(on[ui] ? uu.pm : 0) * BM + (F.tid & (BM - 1))]; }
#pragma unroll
          for (int ui = 0; ui < 8; ++ui) if (on[ui] && F.tid < BM) rs1l[ui * BM + F.tid] = rv[ui];
          LDS_WAIT(); __syncthreads(); }
        EpiIn E{(const PG8_LAS float*)rs1l, (bf16_t*)(ws + WS_U), (bf16_t*)(ws + WS_Q), (float*)(ws + WS_KF), (float*)(ws + WS_VF), (bf16_t*)(ws + WS_GT), (bf16_t*)(ws + WS_KB), (bf16_t*)(ws + WS_VT)};
        gemm_phase<EpiIn, StaticOrder, true, true, true>(F.lds + RING_OFF, g, S, E, tf);
        }
    PH_END(1)
    PH_BEGIN(2) p2a_phase(F, args); PH_END(2)
    PH_BEGIN(3) p2b_phase(F, args); PH_END(3)
    PH_BEGIN(4)
        Gemm g{(const bf16_t*)(ws + WS_G), (const bf16_t*)(ws + WS_WGB), SW}; TripleOrder S; S.init(M, D, SW, F.G, (int)blockIdx.x, 8); const TailFix tf{(unsigned char*)args.out, (unsigned*)(ctl + CW_TAIL + 1 * 8192)};
        EpiMix E{(const bf16_t*)(ws + WS_GT), (bf16_t*)(ws + WS_T), (bf16_t*)(ws + WS_D)};
        gemm_phase<EpiMix, TripleOrder, true, true, true>(F.lds + RING_OFF, g, S, E, tf);
    PH_END(4)
    PH_BEGIN(5)
        Gemm g{(const bf16_t*)(ws + WS_D), (const bf16_t*)(ws + WS_WOUT), D}; StaticOrder S; S.init(M, D, D, F.G, (int)blockIdx.x, 8); const TailFix tf{ws + WS_T, (unsigned*)(ctl + CW_TAIL + 2 * 8192)};
        EpiRes E{nullptr, nullptr, (const bf16_t*)(ws + WS_XB), nullptr, (bf16_t*)(ws + WS_X1B), (float*)(ws + WS_RSS2)};
        gemm_phase<EpiRes, StaticOrder, true, true, true>(F.lds + RING_OFF, g, S, E, tf);
    PH_END(5)
    PH_BEGIN(6)
        Gemm g{(const bf16_t*)(ws + WS_X1B), (const bf16_t*)(ws + WS_WFI), D}; StaticOrder S; S.init(M, 2 * FF, D, F.G, (int)blockIdx.x, 8); const TailFix tf{ws + WS_D, (unsigned*)(ctl + CW_TAIL + 4 * 8192)};
        LAS float* rs2l = (LAS float*)(F.lds + RS2L_OFF);
        { const f32x4* RQ = (const f32x4*)(ws + WS_RSS2); Unit uu; const int trow = F.lane >> 1, th = F.lane & 1;
          f32x4 q[8][4]; bool on[8];
#pragma unroll
          for (int ui = 0; ui < 8; ++ui) { on[ui] = S.next(ui, uu); const f32x4* rq = RQ + (size_t)(4 * th) * M + ((on[ui] ? uu.pm : 0) * BM + F.wave * 32 + trow);
              q[ui][0] = rq[0]; q[ui][1] = rq[M]; q[ui][2] = rq[2 * (size_t)M]; q[ui][3] = rq[3 * (size_t)M]; }
#pragma unroll
          for (int ui = 0; ui < 8; ++ui) { const f32x4 t = (q[ui][0] + q[ui][1]) + (q[ui][2] + q[ui][3]); float sm = (t[0] + t[1]) + (t[2] + t[3]); sm += __shfl_xor(sm, 1);
              if (on[ui] && th == 0) rs2l[ui * BM + F.wave * 32 + trow] = 1.0f / sqrtf(sm * (1.0f / D) + EPS); }
          LDS_WAIT(); __syncthreads(); }
        EpiFfn E{(const PG8_LAS float*)rs2l, (bf16_t*)(ws + WS_ACT)};
        gemm_phase<EpiFfn, StaticOrder, true, true>(F.lds + RING_OFF, g, S, E, tf);
        { const int nid = ffo_late_idle(F.G); const int c = (int)blockIdx.x, lastn = F.G - nid;
          if (nid && c >= lastn) { LAS unsigned* scr = (LAS unsigned*)(F.lds + RING_OFF + F.wave * 16384);
              for (int r = (c - lastn) * NWAVES + F.wave; r < I_FO_ITEMS; r += nid * NWAVES) { const int nb = D / 64, kb = r / nb, n0 = 64 * (r % nb);
                  p0_transpose_item(args.in[24], FF, D, nullptr, (bf16*)(ws + WS_WFO), 64 * kb, n0, n0, scr, F.lane); } } }
    PH_END(6)
    bool fused_final = false;
    if (IN(7)) {
        Gemm g{(const bf16_t*)(ws + WS_ACT), (const bf16_t*)(ws + WS_WFO), FF}; StaticOrder S; S.init(M, D, FF, F.G, (int)blockIdx.x, 8); const TailFix tf{ws + WS_C + (size_t)M * D * 2, (unsigned*)(ctl + CW_TAIL + 3 * 8192)};
        fused_final = multi && IN(8) && DUP_PHASE != 7 && S.T.R == 1 && S.T.r > 0 && S.T.s == 8;
        if (fused_final) {
            S.tfirst = true;
            EpiFinal E{(const bf16_t*)(ws + WS_X1B), (float*)(ws + WS_RSS3), args.out, args.in[25], (LAS float*)(F.lds + RS2L_OFF)};
            const GridSync gs{&bar};
            gemm_phase<EpiFinal, StaticOrder, true, true, true, GridSync>(F.lds + RING_OFF, g, S, E, tf, gs);
        } else {
            for (int rep_ = 0; rep_ < ((DUP_PHASE == 7) ? 2 : 1); ++rep_) { if (rep_) xcd_barrier(bar);
                EpiRes E{nullptr, nullptr, (const bf16_t*)(ws + WS_X1B), nullptr, (bf16_t*)(ws + WS_D), (float*)(ws + WS_RSS3)};
                gemm_phase<EpiRes, StaticOrder, true, true, true>(F.lds + RING_OFF, g, S, E, tf); }
            SEAM(7);
        }
    }
    if (!fused_final) { PH_BEGIN(8) p7_phase(F, args); PH_END(8) }
#undef IN
#undef SEAM
}

#ifndef MK_N_LAUNCHES
#define MK_N_LAUNCHES 1
#endif
extern "C" void kernel_launch(void* const* d_in, const int* in_sizes, int n_in, void* d_out, int out_size, void* d_ws, size_t ws_size, hipStream_t stream) {
    static int grid = 0;
    if (grid == 0) {
        if (n_in != 26 || (size_t)out_size != O_END || ws_size < WS_END) { fprintf(stderr, "kernel_launch: unexpected shapes: n_in %d out %d ws %zu (need %zu)\n", n_in, out_size, ws_size, (size_t)WS_END); grid = -1; return; }
        int dev = 0, cus = 0;
        if (hipGetDevice(&dev) != hipSuccess || hipDeviceGetAttribute(&cus, hipDeviceAttributeMultiprocessorCount, dev) != hipSuccess) { grid = -1; return; }
        if (hipFuncSetAttribute((const void*)mega_fwd, hipFuncAttributeMaxDynamicSharedMemorySize, LDS_BYTES) != hipSuccess) { fprintf(stderr, "kernel_launch: hipFuncSetAttribute failed\n"); grid = -1; return; }
        (void)hipGetLastError();
        grid = cus;
    }
    if (grid < 0) return;
    (void)hipMemsetAsync((char*)d_ws + WS_CTL, 0, CTL_ZERO_BYTES, stream);
    Args a{};
    for (int i = 0; i < 26; ++i) a.in[i] = (const float*)d_in[i];
    a.out = (float*)d_out; a.ws = (unsigned char*)d_ws;
    constexpr int NPH = 9;
    if (MK_N_LAUNCHES == 1) { a.ph_lo = 0; a.ph_hi = NPH; hipLaunchKernelGGL(mega_fwd, dim3(grid), dim3(NWAVES * 64), LDS_BYTES, stream, a); }
    else for (int p = 0; p < NPH; ++p) { a.ph_lo = p; a.ph_hi = p + 1; hipLaunchKernelGGL(mega_fwd, dim3(grid), dim3(NWAVES * 64), LDS_BYTES, stream, a); }
}
```

```cpp
#include <hip/hip_runtime.h>
#include <cstdio>
#include <cstdint>

constexpr int MP = 8192, MS = 512, M = MP + MS;
constexpr int D = 2048, SW = 1024, KVW = 256, NIN = 6656, FF = 5632;
constexpr int SEQ = 4096, NGRP = 64, NSTATE = 64, GCH = 16, NH = 16, HD = 64, NKV = 4, WIN = 128, DECB = 128, DECS = 4;
constexpr float EPS = 1e-6f;
constexpr size_t O_Y = 0, O_PRE = (size_t)M * D, O_PIM = O_PRE + 8192, O_PK = O_PIM + 8192, O_PV = O_PK + 65536, O_SRE = O_PV + 65536,
                 O_SIM = O_SRE + 524288, O_SK = O_SIM + 524288, O_SV = O_SK + 4194304, O_END = O_SV + 4194304;

namespace pg8 {
#define PG8_LAS __attribute__((address_space(3)))
#define PG8_GAS __attribute__((address_space(1)))
typedef unsigned short bf16_t;
typedef short bf16x8 __attribute__((ext_vector_type(8)));
typedef float f32x4 __attribute__((ext_vector_type(4)));
typedef unsigned u32x4 __attribute__((ext_vector_type(4)));
__device__ __forceinline__ u32x4 ntld16(const void* p) { return __builtin_nontemporal_load((const PG8_GAS u32x4*)p); }
constexpr int BM = 256, BK = 64, HALF = 128, HTB = HALF * BK * 2  , STAGE_BYTES = 8 * HTB, NXCD = 8, WGM = 8;

__host__ __device__ __forceinline__ int lds_byte(int r, int c) { const int st = (r >> 4) * 2 + (c >> 5), rr = r & 15, cc = c & 31, ob = rr * 64 + cc * 2; return st * 1024 + (ob ^ (((ob >> 9) & 1) << 5)); }
__host__ __device__ __forceinline__ void stage_rc(int b, int& R, int& C) { const int st = b / 1024, sb = b % 1024, swz = sb ^ (((sb >> 9) & 1) << 5); R = (st >> 1) * 16 + swz / 64; C = (st & 1) * 32 + (swz % 64) / 2; }
__host__ __device__ __forceinline__ int perm32(int rho) { const int n = rho >> 4, i = rho & 15; return 8 * (i >> 2) + 4 * n + (i & 3); }

struct Unit { int pm, pn, pa, pb, kind, kt0, nk, part, slab; };
struct Gemm { const bf16_t* A; const bf16_t* Bt; int K; };

__host__ __device__ __forceinline__ void map_tile(int wgid, int nM, int nN, int& pm, int& pn) {
    const int nwg = nM * nN;
    { const int q = nwg / NXCD, r = nwg % NXCD, xcd = wgid % NXCD, off = wgid / NXCD; wgid = (xcd < r ? xcd * (q + 1) : r * (q + 1) + (xcd - r) * q) + off; }
    const int nig = WGM * nN, gid = wgid / nig, fm = gid * WGM, gsz = (nM - fm) < WGM ? (nM - fm) : WGM;
    pm = fm + ((wgid % nig) % gsz); pn = (wgid % nig) / gsz;
}
struct TailPlan {
    int G, c, R, r, s, tu, tp;
    __host__ __device__ __forceinline__ void init(int nwg, int npairs, int G_, int c_, int smax) {
        G = G_; c = c_; R = nwg / G; r = nwg % G; s = 1; tu = -1; tp = 0;
        if (r > 0) { while (2 * s <= smax && 2 * s * r <= G && 2 * s <= npairs) s *= 2; }
        if (r > 0 && s == 1) { R += 1; r = 0; }
        if (r > 0) { int t, p; if (G % 8 == 0) { const int x = c % 8, y = c / 8; t = (y / s) * 8 + x; p = y % s; } else { t = c / s; p = c % s; }
            if (t < r) { tu = t; tp = p; } }
    }
    __device__ __forceinline__ void uni() { G = __builtin_amdgcn_readfirstlane(G); c = __builtin_amdgcn_readfirstlane(c); R = __builtin_amdgcn_readfirstlane(R); r = __builtin_amdgcn_readfirstlane(r);
        s = __builtin_amdgcn_readfirstlane(s); tu = __builtin_amdgcn_readfirstlane(tu); tp = __builtin_amdgcn_readfirstlane(tp); }
    __host__ __device__ __forceinline__ void krange(int nt, int& kt0, int& nk) const { const int pairs = nt / 2, k0 = tp * pairs / s, k1 = (tp + 1) * pairs / s; kt0 = 2 * k0; nk = 2 * (k1 - k0); }
};
struct StaticOrder {
    static constexpr bool TRIPLE = false;
    int nM, nN, nwg, nt; TailPlan T;
    __host__ __device__ __forceinline__ void init(int M_, int N_, int K_, int G_, int c_, int smax) { nM = M_ / BM; nN = N_ / BM; nwg = nM * nN; nt = K_ / BK; T.init(nwg, nt / 2, G_, c_, smax);
#if defined(__HIP_DEVICE_COMPILE__)
        T.uni();
#endif
    }
    int pmul = 1;
    bool tfirst = false;
    __host__ __device__ __forceinline__ bool next(int i, Unit& u) const { const bool ok = next0(i, u); if (ok && pmul != 1) { u.pn = (u.pn * pmul) % nN; u.pb = u.pn; } return ok; }
    __host__ __device__ __forceinline__ bool next0(int i, Unit& u) const {
        u.kind = i;
        if (tfirst) { const int np = T.tu >= 0 ? 1 : 0;
            if (i < np) { map_tile(T.R * T.G + T.tu, nM, nN, u.pm, u.pn); u.pa = u.pm; u.pb = u.pn; T.krange(nt, u.kt0, u.nk); u.part = T.tp; u.slab = T.tu * T.s + T.tp; return true; }
            const int j = i - np; if (j >= T.R) return false;
            const long L = (long)j * T.G + T.c; if (L >= nwg) return false; map_tile((int)L, nM, nN, u.pm, u.pn); u.pa = u.pm; u.pb = u.pn; u.kt0 = 0; u.nk = nt; u.part = -1; u.slab = 0; return true; }
        if (i < T.R) { const long L = (long)i * T.G + T.c; if (L >= nwg) return false; map_tile((int)L, nM, nN, u.pm, u.pn); u.pa = u.pm; u.pb = u.pn; u.kt0 = 0; u.nk = nt; u.part = -1; u.slab = 0; return true; }
        if (i == T.R && T.tu >= 0) { map_tile(T.R * T.G + T.tu, nM, nN, u.pm, u.pn); u.pa = u.pm; u.pb = u.pn; T.krange(nt, u.kt0, u.nk); u.part = T.tp; u.slab = T.tu * T.s + T.tp; return true; }
        return false;
    }
    __host__ __device__ __forceinline__ int nfix() const { return T.tu >= 0 ? 1 : 0; }
    __host__ __device__ __forceinline__ void fix(int f, Unit& u) const { (void)next(tfirst ? f : T.R + f, u); }
};
struct TripleOrder {
    static constexpr bool TRIPLE = true;
    int nM, nN, nwg, nt; TailPlan T;
    int mode3, tk, tq;
    __host__ __device__ __forceinline__ void init(int M_, int N_, int K_, int G_, int c_, int smax) { nM = M_ / BM; nN = N_ / BM; nwg = nM * nN; nt = K_ / BK; T.init(nwg, nt / 2, G_, c_, smax);
        mode3 = 0; tk = 0; tq = 0;
        if (T.r > 0 && G_ % 8 == 0 && T.r % 8 == 0 && (T.r / 8) * 12 <= G_ / 8 && nt % 8 == 0) {
            mode3 = 1; const int x = c_ % 8, y = c_ / 8, tl = y / 12, p = y % 12;
            if (tl < T.r / 8) { T.tu = tl * 8 + x; T.tp = p; tk = p >> 2; tq = p & 3; } else { T.tu = -1; T.tp = 0; } }
#if defined(__HIP_DEVICE_COMPILE__)
        T.uni(); mode3 = __builtin_amdgcn_readfirstlane(mode3); tk = __builtin_amdgcn_readfirstlane(tk); tq = __builtin_amdgcn_readfirstlane(tq);
#endif
    }
    __host__ __device__ __forceinline__ void fill(Unit& u, int sk) const { u.kind = sk; u.pa = (sk == 2) ? u.pm + nM : u.pm; u.pb = (sk == 2) ? 2 * nN + u.pn : 2 * u.pn + sk; }
    __host__ __device__ __forceinline__ bool next(int i, Unit& u) const {
        const int tr = i / 3, sk = i - 3 * tr;
        if (tr < T.R) { const long L = (long)tr * T.G + T.c; if (L >= nwg) return false; map_tile((int)L, nM, nN, u.pm, u.pn); fill(u, sk); u.kt0 = 0; u.nk = nt; u.part = -1; u.slab = 0; return true; }
        if (mode3) { if (i == 3 * T.R && T.tu >= 0) { map_tile(T.R * T.G + T.tu, nM, nN, u.pm, u.pn); fill(u, tk); u.kt0 = tq * (nt / 4); u.nk = nt / 4; u.part = tq; u.slab = (T.tu * 3 + tk) * 4 + tq; return true; }
            return false; }
        if (tr == T.R && T.tu >= 0) { map_tile(T.R * T.G + T.tu, nM, nN, u.pm, u.pn); fill(u, sk); T.krange(nt, u.kt0, u.nk); u.part = T.tp; u.slab = (T.tu * 3 + sk) * T.s + T.tp; return true; }
        return false;
    }
    __host__ __device__ __forceinline__ int nfix() const { return (mode3 == 0 && T.tu >= 0) ? 3 : 0; }
    __host__ __device__ __forceinline__ void fix(int f, Unit& u) const { (void)next(3 * T.R + f, u); }
};
struct TailFix { unsigned char* slabs; unsigned* cnt; };
__device__ __forceinline__ void uniformize(Unit& u) {
    u.pm = __builtin_amdgcn_readfirstlane(u.pm); u.pn = __builtin_amdgcn_readfirstlane(u.pn); u.pa = __builtin_amdgcn_readfirstlane(u.pa); u.pb = __builtin_amdgcn_readfirstlane(u.pb);
    u.kind = __builtin_amdgcn_readfirstlane(u.kind); u.kt0 = __builtin_amdgcn_readfirstlane(u.kt0); u.nk = __builtin_amdgcn_readfirstlane(u.nk);
    u.part = __builtin_amdgcn_readfirstlane(u.part); u.slab = __builtin_amdgcn_readfirstlane(u.slab);
}

typedef float f32x2_t __attribute__((ext_vector_type(2))); typedef __bf16 bf16x2_t __attribute__((ext_vector_type(2)));
__device__ __forceinline__ unsigned cvt_pk_bf16(float lo, float hi) { const f32x2_t v = {lo, hi}; const bf16x2_t b = __builtin_convertvector(v, bf16x2_t); return __builtin_bit_cast(unsigned, b); }
__device__ __forceinline__ u32x4 pack8(const f32x4 a, const f32x4 b) { u32x4 w; w.x = cvt_pk_bf16(a[0], a[1]); w.y = cvt_pk_bf16(a[2], a[3]); w.z = cvt_pk_bf16(b[0], b[1]); w.w = cvt_pk_bf16(b[2], b[3]); return w; }
__device__ __forceinline__ void unpack8(const u32x4 w, f32x4& a, f32x4& b) {
    a[0] = __uint_as_float(w.x << 16); a[1] = __uint_as_float(w.x & 0xffff0000u); a[2] = __uint_as_float(w.y << 16); a[3] = __uint_as_float(w.y & 0xffff0000u);
    b[0] = __uint_as_float(w.z << 16); b[1] = __uint_as_float(w.z & 0xffff0000u); b[2] = __uint_as_float(w.w << 16); b[3] = __uint_as_float(w.w & 0xffff0000u); }
__device__ __forceinline__ float sigmoidf_(float x) { return __builtin_amdgcn_rcpf(1.0f + __builtin_amdgcn_exp2f(-1.4426950408889634f * x)); }
__device__ __forceinline__ f32x4 sigmoid4(const f32x4 x) { f32x4 r; r[0] = sigmoidf_(x[0]); r[1] = sigmoidf_(x[1]); r[2] = sigmoidf_(x[2]); r[3] = sigmoidf_(x[3]); return r; }
__device__ __forceinline__ float sumsq4(const f32x4 x) { return (x[0] * x[0] + x[1] * x[1]) + (x[2] * x[2] + x[3] * x[3]); }

struct EpiIn {
    static constexpr bool PERM = true, FINAL = false;
    const PG8_LAS float* rs1;   bf16_t* U; bf16_t* Q; float* KF; float* VF; bf16_t* GT; bf16_t* KB; bf16_t* VT;
    __device__ __forceinline__ void operator()(const f32x4 (&acc)[2][2][4][2], const Unit& u, int wr, int wc, int fr, int fq, unsigned rg) const {
        const int row0 = u.pm * BM + wr * 64 + fr, cl = wc * 32 + 8 * fq, pn = u.pn;
#pragma unroll
        for (int ai = 0; ai < 2; ++ai)
#pragma unroll
            for (int m = 0; m < 4; ++m) { if (!((rg >> (ai * 4 + m)) & 1u)) continue; const int row = row0 + ai * HALF + m * 16; const float s = rs1[u.kind * BM + wr * 64 + ai * HALF + m * 16 + fr];
#pragma unroll
                for (int bj = 0; bj < 2; ++bj) { const int cb = bj * HALF + cl; f32x4 v0 = acc[ai][bj][m][0] * s, v1 = acc[ai][bj][m][1] * s;
                    if (pn < 4) { *(u32x4*)(U + (size_t)row * SW + pn * 256 + cb) = pack8(v0, v1); }
                    else if (pn < 8) { v0 = v0 * 0.125f; v1 = v1 * 0.125f; *(u32x4*)(Q + (size_t)row * SW + (pn - 4) * 256 + cb) = pack8(v0, v1); }
                    else if (pn == 8) { if (row >= MP || (row & (SEQ - 1)) >= SEQ - 128) { float* p = KF + (size_t)row * KVW + cb; *(f32x4*)p = v0; *(f32x4*)(p + 4) = v1; }
                        if (row < MP) { const int kvh = cb >> 6, dd = cb & 63, t = row & (SEQ - 1);
                            *(u32x4*)(KB + ((size_t)(((row >> 12) * 4 + kvh) * (SEQ / 32) + (t >> 5))) * 2048 + (dd >> 4) * 512 + ((((dd >> 3) & 1) * 32 + (t & 31)) * 8)) = pack8(v0, v1); } }
                    else if (pn == 9) { if (row >= MP || (row & (SEQ - 1)) >= SEQ - 128) { float* p = VF + (size_t)row * KVW + cb; *(f32x4*)p = v0; *(f32x4*)(p + 4) = v1; }
                        if (row < MP) { const int kvh = cb >> 6, d0 = cb & 63, t = row & (SEQ - 1), kk = t & 31, r16 = kk & 15;
                            bf16_t* vt = VT + ((size_t)(((row >> 12) * 4 + kvh) * (SEQ / 32) + (t >> 5))) * 2048 + ((kk >> 4) * 2 + (d0 >> 5)) * 512 + ((((r16 >> 2) & 1) * 32 + (d0 & 31)) * 8) + 4 * (r16 >> 3) + (r16 & 3);
                            const u32x4 w = pack8(v0, v1);
                            vt[0] = (bf16_t)(w.x & 0xffffu); vt[8] = (bf16_t)(w.x >> 16); vt[16] = (bf16_t)(w.y & 0xffffu); vt[24] = (bf16_t)(w.y >> 16);
                            vt[32] = (bf16_t)(w.z & 0xffffu); vt[40] = (bf16_t)(w.z >> 16); vt[48] = (bf16_t)(w.w & 0xffffu); vt[56] = (bf16_t)(w.w >> 16); } }
                    else { const float sn = s * -1.4426950408889634f; const f32x4 e0 = acc[ai][bj][m][0] * sn, e1 = acc[ai][bj][m][1] * sn;
#pragma unroll
                        for (int i = 0; i < 4; ++i) { v0[i] = __builtin_amdgcn_rcpf(1.0f + __builtin_amdgcn_exp2f(e0[i])); v1[i] = __builtin_amdgcn_rcpf(1.0f + __builtin_amdgcn_exp2f(e1[i])); }
                        *(u32x4*)(GT + (size_t)row * (2 * D) + (pn - 10) * 256 + cb) = pack8(v0, v1); } } }
    }
};
struct EpiMix {
    static constexpr bool PERM = true, FINAL = false;
    const bf16_t* GT; bf16_t* T; bf16_t* MB;
    __device__ __forceinline__ void operator()(const f32x4 (&acc)[2][2][4][2], const Unit& u, int wr, int wc, int fr, int fq, unsigned rg) const {
        const int row0 = u.pm * BM + wr * 64 + fr, cl = wc * 32 + 8 * fq;
        if (u.kind < 2) {
            const int c = (2 * u.pn + u.kind) * HALF + cl;
            u32x4 gq[2][4];
#pragma unroll
            for (int ai = 0; ai < 2; ++ai)
#pragma unroll
                for (int m = 0; m < 4; ++m) gq[ai][m] = ((rg >> (ai * 4 + m)) & 1u) ? ntld16(GT + (size_t)(row0 + ai * HALF + m * 16) * (2 * D) + c) : (u32x4){0u, 0u, 0u, 0u};
#pragma unroll
            for (int ai = 0; ai < 2; ++ai)
#pragma unroll
                for (int m = 0; m < 4; ++m) { if (!((rg >> (ai * 4 + m)) & 1u)) continue; const int row = row0 + ai * HALF + m * 16;
                    f32x4 g0, g1; unpack8(gq[ai][m], g0, g1);
                    const f32x4 t0 = g0 * acc[ai][0][m][0] * sigmoid4(acc[ai][1][m][0]), t1 = g1 * acc[ai][0][m][1] * sigmoid4(acc[ai][1][m][1]);
                    *(u32x4*)(T + (size_t)row * D + c) = pack8(t0, t1); }
        } else {
#pragma unroll
            for (int ai = 0; ai < 2; ++ai) {
                u32x4 gq[4][2], tq[4][2];
#pragma unroll
                for (int m = 0; m < 4; ++m)
#pragma unroll
                    for (int bj = 0; bj < 2; ++bj) { const bool on = (rg >> (ai * 4 + m)) & 1u; const int row = row0 + ai * HALF + m * 16, c = u.pn * BM + bj * HALF + cl;
                        gq[m][bj] = on ? ntld16(GT + (size_t)row * (2 * D) + D + c) : (u32x4){0u, 0u, 0u, 0u}; tq[m][bj] = on ? *(const PG8_GAS u32x4*)(T + (size_t)row * D + c) : (u32x4){0u, 0u, 0u, 0u}; }
#pragma unroll
                for (int m = 0; m < 4; ++m) { if (!((rg >> (ai * 4 + m)) & 1u)) continue; const int row = row0 + ai * HALF + m * 16;
#pragma unroll
                    for (int bj = 0; bj < 2; ++bj) { const int c = u.pn * BM + bj * HALF + cl;
                        f32x4 g0, g1, t0, t1; unpack8(gq[m][bj], g0, g1); unpack8(tq[m][bj], t0, t1);
                        *(u32x4*)(MB + (size_t)row * D + c) = pack8(t0 + g0 * acc[ai][bj][m][0], t1 + g1 * acc[ai][bj][m][1]); } }
            }
        }
    }
    __device__ __forceinline__ void fix3(const f32x4 (&vg)[2][2], const f32x4 (&wg)[2][2], const f32x4 (&br)[2][2], int pm, int pn, int wr, int wc, int fr, int fq, int ai, int m) const {
        const int row = pm * BM + wr * 64 + fr + ai * HALF + m * 16, cl = wc * 32 + 8 * fq;
#pragma unroll
        for (int bj = 0; bj < 2; ++bj) { const int c = pn * BM + bj * HALF + cl;
            f32x4 ga0, ga1, gb0, gb1; unpack8(ntld16(GT + (size_t)row * (2 * D) + c), ga0, ga1); unpack8(ntld16(GT + (size_t)row * (2 * D) + D + c), gb0, gb1);
            const f32x4 (&q)[2][2] = bj == 0 ? vg : wg;
            const f32x4 t0 = ga0 * q[0][0] * sigmoid4(q[1][0]), t1 = ga1 * q[0][1] * sigmoid4(q[1][1]);
            *(u32x4*)(MB + (size_t)row * D + c) = pack8(t0 + gb0 * br[bj][0], t1 + gb1 * br[bj][1]); }
    }
};
struct EpiRes {
    static constexpr bool PERM = true, FINAL = false;
    const float* xp; const float* xs; const bf16_t* rb; float* out; bf16_t* XB; float* RSS;
    __device__ __forceinline__ void operator()(const f32x4 (&acc)[2][2][4][2], const Unit& u, int wr, int wc, int fr, int fq, unsigned rg) const {
        const int row0 = u.pm * BM + wr * 64 + fr, cl = wc * 32 + 8 * fq;
        const float* rbase = (u.pm * BM < MP) ? xp : xs - (size_t)MP * D;
        u32x4 rq[2][4][2];
        if (rb) {
#pragma unroll
            for (int ai = 0; ai < 2; ++ai)
#pragma unroll
                for (int m = 0; m < 4; ++m)
#pragma unroll
                    for (int bj = 0; bj < 2; ++bj) rq[ai][m][bj] = ((rg >> (ai * 4 + m)) & 1u) ? ntld16(rb + (size_t)(row0 + ai * HALF + m * 16) * D + u.pn * BM + bj * HALF + cl) : (u32x4){0u, 0u, 0u, 0u}; }
#pragma unroll
        for (int ai = 0; ai < 2; ++ai)
#pragma unroll
            for (int m = 0; m < 4; ++m) { if (!((rg >> (ai * 4 + m)) & 1u)) continue; const int row = row0 + ai * HALF + m * 16; float ss = 0.f;
#pragma unroll
                for (int bj = 0; bj < 2; ++bj) { const size_t off = (size_t)row * D + u.pn * BM + bj * HALF + cl;
                    f32x4 r0, r1; if (rb) unpack8(rq[ai][m][bj], r0, r1); else { r0 = *(const f32x4*)(rbase + off); r1 = *(const f32x4*)(rbase + off + 4); }
                    const f32x4 v0 = r0 + acc[ai][bj][m][0], v1 = r1 + acc[ai][bj][m][1];
                    ss += sumsq4(v0) + sumsq4(v1);
                    if (out) { *(f32x4*)(out + off) = v0; *(f32x4*)(out + off + 4) = v1; }
                    if (XB) *(u32x4*)(XB + off) = pack8(v0, v1); }
                ss += __shfl_xor(ss, 16); ss += __shfl_xor(ss, 32);
                if (fq == 0) RSS[((size_t)u.pn * M + row) * 4 + wc] = ss; }
    }
};
struct EpiFfn {
    static constexpr bool PERM = true, FINAL = false;
    const PG8_LAS float* RS; bf16_t* ACT;
    __device__ __forceinline__ void operator()(const f32x4 (&acc)[2][2][4][2], const Unit& u, int wr, int wc, int fr, int fq, unsigned rg) const {
        const int row0 = u.pm * BM + wr * 64 + fr, cl = wc * 32 + 8 * fq;
#pragma unroll
        for (int ai = 0; ai < 2; ++ai)
#pragma unroll
            for (int m = 0; m < 4; ++m) { if (!((rg >> (ai * 4 + m)) & 1u)) continue; const int row = row0 + ai * HALF + m * 16;
                const float s = RS[u.kind * BM + wr * 64 + ai * HALF + m * 16 + fr];
                const f32x4 g0 = acc[ai][0][m][0] * s, g1 = acc[ai][0][m][1] * s, u0 = acc[ai][1][m][0] * s, u1 = acc[ai][1][m][1] * s;
                *(u32x4*)(ACT + (size_t)row * FF + u.pn * HALF + cl) = pack8(g0 * sigmoid4(g0) * u0, g1 * sigmoid4(g1) * u1); }
    }
};
struct EpiFinal {
    static constexpr bool PERM = true, FINAL = true;
    const bf16_t* rb; float* RSS; float* out; const float* gf; PG8_LAS float* rt;
    __device__ __forceinline__ void pre_ld(u32x4& q0, u32x4& q1, int row, int pn, int cl) const { const size_t o0 = (size_t)row * D + pn * BM + cl; q0 = ntld16(rb + o0); q1 = ntld16(rb + o0 + HALF); }
    __device__ __forceinline__ void pre_rg(f32x4& a00, f32x4& a01, f32x4& a10, f32x4& a11, int row, int pn, int cl, int wc, int fq) const { u32x4 q0, q1; pre_ld(q0, q1, row, pn, cl); pre_ap(a00, a01, a10, a11, q0, q1, row, pn, wc, fq); }
    __device__ __forceinline__ void pre_ap(f32x4& a00, f32x4& a01, f32x4& a10, f32x4& a11, const u32x4 q0, const u32x4 q1, int row, int pn, int wc, int fq) const {
        f32x4 r0, r1, r2, r3; unpack8(q0, r0, r1); unpack8(q1, r2, r3);
        a00 = a00 + r0; a01 = a01 + r1; a10 = a10 + r2; a11 = a11 + r3;
        float ss = (sumsq4(a00) + sumsq4(a01)) + (sumsq4(a10) + sumsq4(a11));
        ss += __shfl_xor(ss, 16); ss += __shfl_xor(ss, 32);
        if (fq == 0) RSS[((size_t)pn * M + row) * 4 + wc] = ss;
    }
    __device__ __forceinline__ void post_rg(const f32x4& a00, const f32x4& a01, const f32x4& a10, const f32x4& a11, int row, int pn, int cl, float r) const {
        const size_t o0 = (size_t)row * D + pn * BM + cl, o1 = o0 + HALF; const float* g0 = gf + pn * BM + cl; const float* g1 = g0 + HALF;
        *(f32x4*)(out + o0) = a00 * r * *(const f32x4*)g0; *(f32x4*)(out + o0 + 4) = a01 * r * *(const f32x4*)(g0 + 4);
        *(f32x4*)(out + o1) = a10 * r * *(const f32x4*)g1; *(f32x4*)(out + o1 + 4) = a11 * r * *(const f32x4*)(g1 + 4);
    }
};
struct NoSync { __device__ __forceinline__ void operator()() const {} };

template <class Epi, class Sched, bool ALIGN_EPI = false, bool SP2 = false, bool SLAB16 = false, class Sync = NoSync>
__device__ __forceinline__ void gemm_phase(PG8_LAS unsigned char* lds, const Gemm g, const Sched& S, const Epi& E, const TailFix tf, const Sync sync = Sync()) {
    const int tid = threadIdx.x, wid = __builtin_amdgcn_readfirstlane(tid >> 6), lane = tid & 63, wr = wid >> 2, wc = wid & 3, fr = lane & 15, fq = lane >> 4;
    const int K = g.K;
    unsigned voffA[2], voffB[2];
#pragma unroll
    for (int i = 0; i < 2; ++i) { int R, C; stage_rc(tid * 16 + i * 8192, R, C); const int Rb = Epi::PERM ? ((R & ~31) + perm32(R & 31)) : R;
        voffA[i] = (unsigned)(R * K + C) * 2u; voffB[i] = (unsigned)(Rb * K + C) * 2u; }
    const size_t kstep = (size_t)(BK * 2);
    const size_t hstep = (size_t)HALF * K * 2;
    const size_t tstep = 2 * hstep;
    const unsigned ldsw = (unsigned)wid * 1024u;
    const int aoff = lds_byte(wr * 64 + fr, fq * 8), boff = lds_byte(wc * 32 + fr, fq * 8);
#define PG8_SA(b, h) (((b) * 2 + (h)) * HTB)
#define PG8_SB(b, h) ((4 + (b) * 2 + (h)) * HTB)
#define PG8_STAGE(bufoff, gbase, voff) do { _Pragma("unroll") for (int _i = 0; _i < 2; ++_i) \
        __builtin_amdgcn_global_load_lds((const unsigned*)((const char*)(gbase) + (voff)[_i]), (PG8_LAS unsigned*)(lds + (bufoff) + ldsw + _i * 8192), 16, 0, 0); } while (0)
#define PG8_LDA(dst, b, h) do { _Pragma("unroll") for (int m = 0; m < 4; ++m) _Pragma("unroll") for (int k = 0; k < 2; ++k) dst[m][k] = *(const PG8_LAS bf16x8*)(lds + PG8_SA(b, h) + aoff + m * 2048 + k * 1024); } while (0)
#define PG8_LDB(dst, b, h) do { _Pragma("unroll") for (int n = 0; n < 2; ++n) _Pragma("unroll") for (int k = 0; k < 2; ++k) dst[n][k] = *(const PG8_LAS bf16x8*)(lds + PG8_SB(b, h) + boff + n * 2048 + k * 1024); } while (0)
#define PG8_MMA(ai, bj, At, Bt) do { __builtin_amdgcn_s_setprio(1); _Pragma("unroll") for (int m = 0; m < 4; ++m) _Pragma("unroll") for (int n = 0; n < 2; ++n) _Pragma("unroll") for (int k = 0; k < 2; ++k) \
        acc[ai][bj][m][n] = __builtin_amdgcn_mfma_f32_16x16x32_bf16(Bt[n][k], At[m][k], acc[ai][bj][m][n], 0, 0, 0); __builtin_amdgcn_s_setprio(0); } while (0)
#define PG8_WAIT_V(n) asm volatile("s_waitcnt vmcnt(" #n ")" ::: "memory")
#define PG8_WAIT_L(n) asm volatile("s_waitcnt lgkmcnt(" #n ")" ::: "memory")
#define PG8_BAR __builtin_amdgcn_s_barrier()
#define PG8_SCHED __builtin_amdgcn_sched_barrier(0)
    Unit cur, nxt; int ui = 0;
    if (!S.next(0, cur)) return;
    uniformize(cur);
    f32x4 acc[2][2][4][2];
#pragma unroll
    for (int a = 0; a < 2; ++a)
#pragma unroll
        for (int b = 0; b < 2; ++b)
#pragma unroll
            for (int m = 0; m < 4; ++m)
#pragma unroll
                for (int n = 0; n < 2; ++n) acc[a][b][m][n] = (f32x4){0.f, 0.f, 0.f, 0.f};
    bf16x8 At[4][2], B0[2][2], B1[2][2];
    const char* cA = (const char*)g.A + (size_t)cur.pa * tstep + (size_t)cur.kt0 * kstep; const char* cB = (const char*)g.Bt + (size_t)cur.pb * tstep + (size_t)cur.kt0 * kstep;
    if constexpr (SP2) {
        PG8_STAGE(PG8_SB(0, 0), cB, voffB); PG8_STAGE(PG8_SB(0, 1), cB + hstep, voffB); PG8_STAGE(PG8_SA(0, 0), cA, voffA); PG8_STAGE(PG8_SA(0, 1), cA + hstep, voffA);
        if (wr == 1) PG8_BAR;
        PG8_WAIT_V(2); PG8_BAR;
        PG8_STAGE(PG8_SB(1, 0), cB + kstep, voffB); PG8_STAGE(PG8_SA(1, 0), cA + kstep, voffA); PG8_STAGE(PG8_SB(1, 1), cB + hstep + kstep, voffB);
        PG8_WAIT_V(6); PG8_BAR;
    } else {
        PG8_STAGE(PG8_SB(0, 0), cB, voffB); PG8_STAGE(PG8_SA(0, 0), cA, voffA); PG8_STAGE(PG8_SB(0, 1), cB + hstep, voffB); PG8_STAGE(PG8_SA(0, 1), cA + hstep, voffA);
        if (wr == 1) PG8_BAR;
        PG8_WAIT_V(4); PG8_BAR;
        PG8_STAGE(PG8_SB(1, 0), cB + kstep, voffB); PG8_STAGE(PG8_SA(1, 0), cA + kstep, voffA); PG8_STAGE(PG8_SB(1, 1), cB + hstep + kstep, voffB);
        PG8_WAIT_V(6); PG8_BAR;
    }
    for (;;) {
        const bool has_next = S.next(ui + 1, nxt); if (has_next) uniformize(nxt);
        const char* nA = has_next ? (const char*)g.A + (size_t)nxt.pa * tstep + (size_t)nxt.kt0 * kstep : cA; const char* nB = has_next ? (const char*)g.Bt + (size_t)nxt.pb * tstep + (size_t)nxt.kt0 * kstep : cB;
        const int nt = cur.nk;
        for (int t = 0; t < nt; t += 2) {
            const bool last = (t == nt - 2);
            const char* a1 = cA + (size_t)(t + 1) * kstep;
            const char* a2 = last ? nA : cA + (size_t)(t + 2) * kstep; const char* b2 = last ? nB : cB + (size_t)(t + 2) * kstep;
            const char* a3 = a2 + kstep; const char* b3 = b2 + kstep;
            if constexpr (SP2) {
            PG8_LDB(B0, 0, 0); PG8_LDB(B1, 0, 1); PG8_SCHED; PG8_LDA(At, 0, 0); PG8_STAGE(PG8_SA(1, 1), a1 + hstep, voffA);
            PG8_WAIT_V(8); PG8_WAIT_L(0); PG8_BAR; PG8_MMA(0, 0, At, B0); PG8_MMA(0, 1, At, B1); PG8_BAR; PG8_SCHED;
            PG8_LDA(At, 0, 1); PG8_STAGE(PG8_SB(0, 0), b2, voffB); PG8_STAGE(PG8_SB(0, 1), b2 + hstep, voffB); PG8_STAGE(PG8_SA(0, 0), a2, voffA);
            PG8_WAIT_V(8); PG8_WAIT_L(0); PG8_BAR; PG8_MMA(1, 0, At, B0); PG8_MMA(1, 1, At, B1); PG8_BAR; PG8_SCHED;
            PG8_LDB(B0, 1, 0); PG8_LDB(B1, 1, 1); PG8_SCHED; PG8_LDA(At, 1, 0); PG8_STAGE(PG8_SA(0, 1), a2 + hstep, voffA);
            PG8_WAIT_V(8); PG8_WAIT_L(0); PG8_BAR; PG8_MMA(0, 0, At, B0); PG8_MMA(0, 1, At, B1); PG8_BAR; PG8_SCHED;
            PG8_LDA(At, 1, 1); PG8_STAGE(PG8_SB(1, 0), b3, voffB); PG8_STAGE(PG8_SB(1, 1), b3 + hstep, voffB); PG8_STAGE(PG8_SA(1, 0), a3, voffA);
            PG8_WAIT_V(8); PG8_WAIT_L(0); PG8_BAR; PG8_MMA(1, 0, At, B0); PG8_MMA(1, 1, At, B1); PG8_BAR; PG8_SCHED;
            } else {
            PG8_LDB(B0, 0, 0); PG8_SCHED; PG8_LDA(At, 0, 0); PG8_STAGE(PG8_SA(1, 1), a1 + hstep, voffA);
            PG8_WAIT_L(8); PG8_BAR; PG8_WAIT_L(0); PG8_MMA(0, 0, At, B0); PG8_BAR; PG8_SCHED;
            PG8_LDB(B1, 0, 1); PG8_STAGE(PG8_SB(0, 0), b2, voffB);
            PG8_BAR; PG8_WAIT_L(0); PG8_MMA(0, 1, At, B1); PG8_BAR;
            PG8_LDA(At, 0, 1); PG8_STAGE(PG8_SA(0, 0), a2, voffA);
            PG8_BAR; PG8_WAIT_L(0); PG8_MMA(1, 0, At, B0); PG8_BAR; PG8_SCHED;
            PG8_STAGE(PG8_SB(0, 1), b2 + hstep, voffB);
            PG8_WAIT_V(6); PG8_BAR; PG8_MMA(1, 1, At, B1); PG8_BAR;
            PG8_LDB(B0, 1, 0); PG8_SCHED; PG8_LDA(At, 1, 0); PG8_STAGE(PG8_SA(0, 1), a2 + hstep, voffA);
            PG8_WAIT_L(8); PG8_BAR; PG8_WAIT_L(0); PG8_MMA(0, 0, At, B0); PG8_BAR; PG8_SCHED;
            PG8_LDB(B1, 1, 1); PG8_STAGE(PG8_SB(1, 0), b3, voffB);
            PG8_BAR; PG8_WAIT_L(0); PG8_MMA(0, 1, At, B1); PG8_BAR;
            PG8_LDA(At, 1, 1); PG8_STAGE(PG8_SA(1, 0), a3, voffA);
            PG8_BAR; PG8_WAIT_L(0); PG8_MMA(1, 0, At, B0); PG8_BAR; PG8_SCHED;
            PG8_STAGE(PG8_SB(1, 1), b3 + hstep, voffB);
            PG8_WAIT_V(6); PG8_BAR; PG8_MMA(1, 1, At, B1); PG8_BAR;
            }
        }
        if constexpr (ALIGN_EPI) { if (wr == 0) PG8_BAR; }
        int fr_e = fr, fq_e = fq, tid_e = tid; asm volatile("" : "+v"(fr_e), "+v"(fq_e), "+v"(tid_e));
        if (cur.part < 0) { if constexpr (!Epi::FINAL) E(acc, cur, wr, wc, fr_e, fq_e, 0xffu); }
        else {
            const __amdgpu_buffer_rsrc_t srs = __builtin_amdgcn_make_buffer_rsrc((void*)tf.slabs, (short)0, 0x7ffff000, 0x00020000);
            constexpr unsigned SLB = SLAB16 ? 131072u : 262144u;
            unsigned so = (unsigned)cur.slab * SLB + (unsigned)tid_e * 16u;
#pragma unroll
            for (int a = 0; a < 2; ++a)
#pragma unroll
                for (int b = 0; b < 2; ++b)
#pragma unroll
                    for (int m = 0; m < 4; ++m) {
                        if constexpr (SLAB16) { __builtin_amdgcn_raw_buffer_store_b128(pack8(acc[a][b][m][0], acc[a][b][m][1]), srs, so, 0, 16); so += 8192u; asm volatile("" : "+v"(so)); }
                        else {
#pragma unroll
                            for (int n = 0; n < 2; ++n) { __builtin_amdgcn_raw_buffer_store_b128(__builtin_bit_cast(u32x4, acc[a][b][m][n]), srs, so, 0, 16); so += 8192u; asm volatile("" : "+v"(so)); } } }
        }
        if (!has_next) break;
#pragma unroll
        for (int a = 0; a < 2; ++a)
#pragma unroll
            for (int b = 0; b < 2; ++b)
#pragma unroll
                for (int m = 0; m < 4; ++m)
#pragma unroll
                    for (int n = 0; n < 2; ++n) acc[a][b][m][n] = (f32x4){0.f, 0.f, 0.f, 0.f};
        cur = nxt; cA = nA; cB = nB; ++ui;
        if constexpr (ALIGN_EPI) { if (wr == 1) PG8_BAR; }
    }
    PG8_WAIT_V(0);
    if constexpr (!ALIGN_EPI) { if (wr == 0) PG8_BAR; }
    PG8_BAR;
    if constexpr (Epi::FINAL) {
        int fr_f = fr, fq_f = fq, tid_f = tid; asm volatile("" : "+v"(fr_f), "+v"(fq_f), "+v"(tid_f));
        const int cl = wc * 32 + 8 * fq_f, row0 = cur.pm * BM + wr * 64 + fr_f;
        { u32x4 rq[2][4][2];
#pragma unroll
          for (int ai = 0; ai < 2; ++ai)
#pragma unroll
              for (int m = 0; m < 4; ++m) E.pre_ld(rq[ai][m][0], rq[ai][m][1], row0 + ai * HALF + m * 16, cur.pn, cl);
#pragma unroll
          for (int ai = 0; ai < 2; ++ai)
#pragma unroll
              for (int m = 0; m < 4; ++m) E.pre_ap(acc[ai][0][m][0], acc[ai][0][m][1], acc[ai][1][m][0], acc[ai][1][m][1], rq[ai][m][0], rq[ai][m][1], row0 + ai * HALF + m * 16, cur.pn, wc, fq_f); }
        f32x4 p00 = {0.f, 0.f, 0.f, 0.f}, p01 = p00, p10 = p00, p11 = p00; Unit fu = cur; int prow = 0; const bool hasfix = S.nfix() > 0;
        if (hasfix) {
            const int sN = S.T.s;
            asm volatile("s_waitcnt vmcnt(0)" ::: "memory"); __syncthreads();
            if (tid == 0) { unsigned* cw = tf.cnt + 64 * S.T.tu; __hip_atomic_fetch_add(cw, 1u, __ATOMIC_RELAXED, __HIP_MEMORY_SCOPE_AGENT); unsigned sp = 0;
                while (__hip_atomic_load(cw, __ATOMIC_RELAXED, __HIP_MEMORY_SCOPE_AGENT) < (unsigned)sN) { __builtin_amdgcn_s_sleep(2); if (++sp > (1u << 22)) break; }
                __builtin_amdgcn_fence(__ATOMIC_ACQUIRE, "agent"); asm volatile("s_waitcnt vmcnt(0)" ::: "memory"); }
            __syncthreads();
            S.fix(0, fu); uniformize(fu);
            const int fai = S.T.tp >> 2, fm = S.T.tp & 3;
            const __amdgpu_buffer_rsrc_t srs = __builtin_amdgcn_make_buffer_rsrc((void*)tf.slabs, (short)0, 0x7ffff000, 0x00020000);
            const unsigned sl0 = (unsigned)(fu.slab - fu.part) * 131072u + (unsigned)tid_f * 16u;
#pragma unroll
            for (int b = 0; b < 2; ++b) { unsigned p = sl0 + (unsigned)((fai * 2 + b) * 4 + fm) * 8192u; asm volatile("" : "+v"(p));
                f32x4 v0, v1; unpack8(__builtin_amdgcn_raw_buffer_load_b128(srs, p, 0, 16), v0, v1);
                { u32x4 wq[7];
#pragma unroll
                  for (int j = 1; j < 8; ++j) { wq[j - 1] = (j < sN) ? __builtin_amdgcn_raw_buffer_load_b128(srs, p + (unsigned)j * 131072u, 0, 16) : (u32x4){0u, 0u, 0u, 0u}; }
#pragma unroll
                  for (int j = 1; j < 8; ++j) { f32x4 w0, w1; unpack8(wq[j - 1], w0, w1); v0 = v0 + w0; v1 = v1 + w1; } }
                if (b == 0) { p00 = v0; p01 = v1; } else { p10 = v0; p11 = v1; } }
            prow = fu.pm * BM + wr * 64 + fr_f + fai * HALF + fm * 16;
            E.pre_rg(p00, p01, p10, p11, prow, fu.pn, cl, wc, fq_f);
        }
        sync();
        {
            const int trow = lane >> 1, th = lane & 1;
            const f32x4* rq = (const f32x4*)E.RSS + (size_t)(4 * th) * M + (cur.pm * BM + wid * 32 + trow);
            f32x4 q0 = rq[0], q1 = rq[M], q2 = rq[2 * (size_t)M], q3 = rq[3 * (size_t)M];
            f32x4 z0 = {0.f, 0.f, 0.f, 0.f}, z1 = z0, z2 = z0, z3 = z0;
            if (hasfix && wid == 0) { const int fai = S.T.tp >> 2, fm = S.T.tp & 3; const int prw = fu.pm * BM + fai * HALF + (trow >> 4) * 64 + fm * 16 + (trow & 15);
                const f32x4* pq = (const f32x4*)E.RSS + (size_t)(4 * th) * M + prw; z0 = pq[0]; z1 = pq[M]; z2 = pq[2 * (size_t)M]; z3 = pq[3 * (size_t)M]; }
            q0 = (q0 + q1) + (q2 + q3); float sm = (q0[0] + q0[1]) + (q0[2] + q0[3]); sm += __shfl_xor(sm, 1);
            if (th == 0) E.rt[wid * 32 + trow] = 1.0f / sqrtf(sm * (1.0f / D) + EPS);
            if (hasfix && wid == 0) { z0 = (z0 + z1) + (z2 + z3); float sp2 = (z0[0] + z0[1]) + (z0[2] + z0[3]); sp2 += __shfl_xor(sp2, 1); if (th == 0) E.rt[256 + trow] = 1.0f / sqrtf(sp2 * (1.0f / D) + EPS); }
            asm volatile("s_waitcnt lgkmcnt(0)" ::: "memory"); __syncthreads();
        }
        {
            const int ccol = (wc * 32 + fq_f * 8) >> 2;
#pragma unroll
            for (int ai = 0; ai < 2; ++ai) {
#pragma unroll
                for (int m = 0; m < 4; ++m) { const int rloc = wr * 64 + m * 16 + fr_f; PG8_LAS unsigned char* rowp = lds + rloc * 1024;
#pragma unroll
                    for (int bj = 0; bj < 2; ++bj)
#pragma unroll
                        for (int n = 0; n < 2; ++n) *(PG8_LAS f32x4*)(rowp + (((bj * 32 + ccol + n) ^ (rloc & 7)) * 16)) = acc[ai][bj][m][n]; }
                asm volatile("s_waitcnt lgkmcnt(0)" ::: "memory"); __syncthreads();
                const f32x4 g4 = *(const f32x4*)(E.gf + cur.pn * BM + 4 * lane);
#pragma unroll 4
                for (int k = 0; k < 16; ++k) { const int rloc = wid * 16 + k; const f32x4 v = *(const PG8_LAS f32x4*)(lds + rloc * 1024 + ((lane ^ (rloc & 7)) * 16));
                    const float r = E.rt[ai * HALF + rloc];
                    __builtin_nontemporal_store(v * r * g4, (PG8_GAS f32x4*)(E.out + (size_t)(cur.pm * BM + ai * HALF + rloc) * D + cur.pn * BM + 4 * lane)); }
                asm volatile("s_waitcnt lgkmcnt(0)" ::: "memory"); __syncthreads();
            }
            if (hasfix) {
                const int rloc = wr * 16 + fr_f; PG8_LAS unsigned char* rowp = lds + rloc * 1024;
                *(PG8_LAS f32x4*)(rowp + (((ccol) ^ (rloc & 7)) * 16)) = p00; *(PG8_LAS f32x4*)(rowp + (((ccol + 1) ^ (rloc & 7)) * 16)) = p01;
                *(PG8_LAS f32x4*)(rowp + (((32 + ccol) ^ (rloc & 7)) * 16)) = p10; *(PG8_LAS f32x4*)(rowp + (((32 + ccol + 1) ^ (rloc & 7)) * 16)) = p11;
                asm volatile("s_waitcnt lgkmcnt(0)" ::: "memory"); __syncthreads();
                const f32x4 g4 = *(const f32x4*)(E.gf + fu.pn * BM + 4 * lane); const int fai = S.T.tp >> 2, fm = S.T.tp & 3;
#pragma unroll
                for (int k = 0; k < 4; ++k) { const int rl = wid * 4 + k; const f32x4 v = *(const PG8_LAS f32x4*)(lds + rl * 1024 + ((lane ^ (rl & 7)) * 16));
                    const float r = E.rt[256 + rl]; const int grow = fu.pm * BM + fai * HALF + (rl >> 4) * 64 + fm * 16 + (rl & 15);
                    __builtin_nontemporal_store(v * r * g4, (PG8_GAS f32x4*)(E.out + (size_t)grow * D + fu.pn * BM + 4 * lane)); }
            }
        }
    }
    if constexpr (Sched::TRIPLE) if (S.mode3 && S.T.tu >= 0) {
        int fr_f = fr, fq_f = fq, tid_f = tid; asm volatile("" : "+v"(fr_f), "+v"(fq_f), "+v"(tid_f));
        const int rgi = S.T.tp;
        asm volatile("s_waitcnt vmcnt(0)" ::: "memory"); __syncthreads();
        if (tid == 0) {
            unsigned* cw = tf.cnt + 64 * S.T.tu;
            __hip_atomic_fetch_add(cw, 1u, __ATOMIC_RELAXED, __HIP_MEMORY_SCOPE_AGENT);
            if (rgi < 8) { unsigned sp = 0;
                while (__hip_atomic_load(cw, __ATOMIC_RELAXED, __HIP_MEMORY_SCOPE_AGENT) < 12u) { __builtin_amdgcn_s_sleep(2); if (++sp > (1u << 22)) break; }
                __builtin_amdgcn_fence(__ATOMIC_ACQUIRE, "agent"); asm volatile("s_waitcnt vmcnt(0)" ::: "memory"); }
        }
        __syncthreads();
        if (rgi < 8) {
            const int fa = rgi >> 2, fm = rgi & 3;
            const __amdgpu_buffer_rsrc_t srs = __builtin_amdgcn_make_buffer_rsrc((void*)tf.slabs, (short)0, 0x7ffff000, 0x00020000);
            static_assert(SLAB16 || !Sched::TRIPLE, "triple parts keep bf16 slabs");
            u32x4 w[3][2][4];
#pragma unroll
            for (int k = 0; k < 3; ++k)
#pragma unroll
                for (int b = 0; b < 2; ++b)
#pragma unroll
                    for (int q = 0; q < 4; ++q) w[k][b][q] = __builtin_amdgcn_raw_buffer_load_b128(srs, (unsigned)(((S.T.tu * 3 + k) * 4 + q)) * 131072u + (unsigned)((fa * 2 + b) * 4 + fm) * 8192u + (unsigned)tid_f * 16u, 0, 16);
            f32x4 sm[3][2][2];
#pragma unroll
            for (int k = 0; k < 3; ++k)
#pragma unroll
                for (int b = 0; b < 2; ++b) { f32x4 v0, v1; unpack8(w[k][b][0], v0, v1);
#pragma unroll
                    for (int q = 1; q < 4; ++q) { f32x4 x0, x1; unpack8(w[k][b][q], x0, x1); v0 = v0 + x0; v1 = v1 + x1; }
                    sm[k][b][0] = v0; sm[k][b][1] = v1; }
            int pm_, pn_; map_tile(S.T.R * S.T.G + S.T.tu, S.nM, S.nN, pm_, pn_); pm_ = __builtin_amdgcn_readfirstlane(pm_); pn_ = __builtin_amdgcn_readfirstlane(pn_);
            E.fix3(sm[0], sm[1], sm[2], pm_, pn_, wr, wc, fr_f, fq_f, fa, fm);
        }
    }
    if constexpr (!Epi::FINAL) if (S.nfix() > 0) {
        const int sN = S.T.s;
        int fr_f = fr, fq_f = fq, tid_f = tid; asm volatile("" : "+v"(fr_f), "+v"(fq_f), "+v"(tid_f));
        asm volatile("s_waitcnt vmcnt(0)" ::: "memory"); __syncthreads();
        if (tid == 0) {
            unsigned* cw = tf.cnt + 64 * S.T.tu;
            __hip_atomic_fetch_add(cw, 1u, __ATOMIC_RELAXED, __HIP_MEMORY_SCOPE_AGENT);
            unsigned sp = 0;
            while (__hip_atomic_load(cw, __ATOMIC_RELAXED, __HIP_MEMORY_SCOPE_AGENT) < (unsigned)sN) { __builtin_amdgcn_s_sleep(2); if (++sp > (1u << 22)) break; }
            __builtin_amdgcn_fence(__ATOMIC_ACQUIRE, "agent"); asm volatile("s_waitcnt vmcnt(0)" ::: "memory");
        }
        __syncthreads();
        const int per = 8 / sN; const unsigned rg = ((1u << per) - 1u) << (per * S.T.tp);
        for (int f = 0; f < S.nfix(); ++f) {
            Unit fu; S.fix(f, fu); uniformize(fu);
            const __amdgpu_buffer_rsrc_t srs = __builtin_amdgcn_make_buffer_rsrc((void*)tf.slabs, (short)0, 0x7ffff000, 0x00020000);
            constexpr unsigned SLB = SLAB16 ? 131072u : 262144u;
            const unsigned sl0 = (unsigned)(fu.slab - fu.part) * SLB + (unsigned)tid_f * 16u;
#pragma unroll
            for (int a = 0; a < 2; ++a)
#pragma unroll
                for (int m = 0; m < 4; ++m) { if (!((rg >> (a * 4 + m)) & 1u)) continue;
#pragma unroll
                    for (int b = 0; b < 2; ++b) {
                        if constexpr (SLAB16) { unsigned p = sl0 + (unsigned)((a * 2 + b) * 4 + m) * 8192u; asm volatile("" : "+v"(p));
                            f32x4 v0, v1; unpack8(__builtin_amdgcn_raw_buffer_load_b128(srs, p, 0, 16), v0, v1);
                            { u32x4 wq[7];
#pragma unroll
                              for (int j = 1; j < 8; ++j) { wq[j - 1] = (j < sN) ? __builtin_amdgcn_raw_buffer_load_b128(srs, p + (unsigned)j * SLB, 0, 16) : (u32x4){0u, 0u, 0u, 0u}; }
#pragma unroll
                              for (int j = 1; j < 8; ++j) { f32x4 w0, w1; unpack8(wq[j - 1], w0, w1); v0 = v0 + w0; v1 = v1 + w1; } }
                            acc[a][b][m][0] = v0; acc[a][b][m][1] = v1; }
                        else {
#pragma unroll
                            for (int n = 0; n < 2; ++n) { unsigned p = sl0 + (unsigned)(((a * 2 + b) * 4 + m) * 2 + n) * 8192u; asm volatile("" : "+v"(p));
                                f32x4 v = __builtin_bit_cast(f32x4, __builtin_amdgcn_raw_buffer_load_b128(srs, p, 0, 16));
                                for (int j = 1; j < sN; ++j) { p += SLB; v = v + __builtin_bit_cast(f32x4, __builtin_amdgcn_raw_buffer_load_b128(srs, p, 0, 16)); } acc[a][b][m][n] = v; } } } }
            E(acc, fu, wr, wc, fr_f, fq_f, rg);
        }
    }
#undef PG8_SA
#undef PG8_SB
#undef PG8_STAGE
#undef PG8_LDA
#undef PG8_LDB
#undef PG8_MMA
#undef PG8_WAIT_V
#undef PG8_WAIT_L
#undef PG8_BAR
#undef PG8_SCHED
}
}

constexpr size_t MiB = 1u << 20;
constexpr size_t WS_CTL = 0, CTL_ZERO_BYTES = 256 * 1024;
constexpr size_t WS_WIN = 1 * MiB;
constexpr size_t WS_WGB = WS_WIN + (size_t)NIN * D * 2;
constexpr size_t WS_WOUT = WS_WGB + (size_t)6144 * SW * 2;
constexpr size_t WS_WFI = WS_WOUT + (size_t)D * D * 2;
constexpr size_t WS_WFO = WS_WFI + (size_t)2 * FF * D * 2;
constexpr size_t WS_A = WS_WFO + (size_t)D * FF * 2;
constexpr size_t WS_XB = WS_A, WS_U = WS_A + (size_t)M * D * 2, WS_Q = WS_U + (size_t)M * SW * 2, WS_T = WS_A + (size_t)M * D * 2;
constexpr size_t WS_B = WS_A + (size_t)M * D * 4;
constexpr size_t WS_KF = WS_B, WS_VF = WS_KF + (size_t)M * KVW * 4, WS_G = WS_VF + (size_t)M * KVW * 4, WS_O = WS_G + (size_t)M * SW * 2;
constexpr size_t WS_C = WS_O + (size_t)M * SW * 2;
constexpr size_t WS_GT = WS_C, WS_X1B = WS_C;
constexpr size_t WS_D = WS_C + (size_t)M * 2 * D * 2;
constexpr size_t WS_E = WS_D + (size_t)M * D * 2;
constexpr size_t WS_RS1 = WS_E, WS_RSS2 = WS_RS1 + (size_t)M * 4, WS_RSS3 = WS_RSS2 + (size_t)M * 32 * 4, WS_KB = WS_RSS3 + (size_t)M * 32 * 4, WS_VT = WS_KB + (size_t)M * KVW * 2,
                 WS_SSMC = WS_VT + (size_t)2 * KVW * SEQ * 2, WS_HLOC = WS_SSMC + (size_t)64 * 2304 * 4, WS_END = WS_HLOC + (size_t)2 * 64 * 16 * 128 * 4;
constexpr size_t WS_ACT = WS_A;
static_assert((size_t)M * FF * 2 <= WS_C - WS_A, "act overlay");
static_assert(WS_O == WS_G + (size_t)M * SW * 2, "g and o contiguous (A tile select in P3)");
constexpr int CW_BAR = 4096, CW_TAIL = 16384;

constexpr int RING_OFF = 0, RING_BYTES = 131072;
constexpr int LDSCTL_OFF = RING_BYTES, MISC_OFF = LDSCTL_OFF + 320;
constexpr int RS2L_OFF = 131072 + 1024;
constexpr int LDS_BYTES = 147456;
constexpr int NWAVES = 8;

#define GAS __attribute__((address_space(1)))
#define LAS __attribute__((address_space(3)))
typedef unsigned short bf16;
typedef unsigned v4u __attribute__((ext_vector_type(4)));
typedef float f32x4 __attribute__((ext_vector_type(4)));
typedef GAS unsigned gu32;
#define RLX_AGENT __ATOMIC_RELAXED, __HIP_MEMORY_SCOPE_AGENT
#define LDS_WAIT() asm volatile("s_waitcnt lgkmcnt(0)" ::: "memory")
#define VM_WAIT() asm volatile("s_waitcnt vmcnt(0)" ::: "memory")
__device__ __forceinline__ unsigned f2bf(float f) { unsigned u = __builtin_bit_cast(unsigned, f); return (u + 0x7fffu + ((u >> 16) & 1u)) >> 16; }
__device__ __forceinline__ unsigned pk2(float lo, float hi) { return f2bf(lo) | (f2bf(hi) << 16); }
__device__ __forceinline__ float bf2f(unsigned short b) { return __uint_as_float((unsigned)b << 16); }

#define XB_TMO      128
#define XB_XCNT(j)  (256  + 64 * (j))
#define XB_XSUB(j)  (1280 + 64 * (j))
#define XB_XGEN(j)  (2304 + 64 * (j))
#define XB_TOP      3328
#define XB_TOPGEN   3392
#define XCD_BAR_WORDS 3456
#define XB_SPIN_CAP (1u << 22)
__device__ __forceinline__ unsigned xb_ld(unsigned* p)              { return __hip_atomic_load(p, __ATOMIC_RELAXED, __HIP_MEMORY_SCOPE_AGENT); }
__device__ __forceinline__ unsigned xb_add(unsigned* p, unsigned v) { return __hip_atomic_fetch_add(p, v, __ATOMIC_RELAXED, __HIP_MEMORY_SCOPE_AGENT); }
__device__ __forceinline__ unsigned xb_xcc_id() { return (unsigned)__builtin_amdgcn_s_getreg((3 << 11) | 20) & 0xFu; }
#define XB_SPIN(cond, bar) do { unsigned _sp = 0; while (cond) { __builtin_amdgcn_s_sleep(1); \
    if ((++_sp & 255u) == 0u) { if (xb_ld(&(bar)[XB_TMO])) break; if (_sp > XB_SPIN_CAP) { atomicAdd(&(bar)[XB_TMO], 1u); break; } } } } while (0)
struct XcdBarrier { unsigned* bar; unsigned x; volatile LAS unsigned* st; };
__device__ __forceinline__ XcdBarrier xcd_barrier_post(unsigned* bar, volatile LAS unsigned* st) {
    XcdBarrier b; b.bar = bar; b.x = xb_xcc_id(); b.st = st;
    if (threadIdx.x == 0) (void)xb_add(&bar[XB_XCNT(b.x)], 1u);
    return b;
}
__device__ __forceinline__ void xcd_barrier_complete(unsigned* bar, unsigned x, unsigned& nloc, unsigned& nx) {
    const unsigned G = gridDim.x * gridDim.y * gridDim.z;
    unsigned sum, cnt, mine, sp = 0u;
    for (;;) {
        sum = 0u; cnt = 0u; mine = 0u;
#pragma unroll
        for (unsigned j = 0; j < 16; ++j) { const unsigned c = xb_ld(&bar[XB_XCNT(j)]); sum += c; cnt += (c > 0u) ? 1u : 0u; mine = (j == x) ? c : mine; }
        if (sum == G) break;
        __builtin_amdgcn_s_sleep(1);
        if ((++sp & 255u) == 0u) { if (xb_ld(&bar[XB_TMO])) break; if (sp > XB_SPIN_CAP) { atomicAdd(&bar[XB_TMO], 1u); break; } }
    }
    nloc = mine > 0u ? mine : 1u; nx = cnt > 0u ? cnt : 1u;
}
__device__ __forceinline__ void xcd_barrier(const XcdBarrier& b) {
    asm volatile("s_waitcnt vmcnt(0)" ::: "memory");
    __syncthreads();
    if (threadIdx.x == 0) {
        unsigned* bar = b.bar;
        __builtin_amdgcn_s_waitcnt(0);
        unsigned nloc = b.st[0], nx = b.st[1];
        if (nloc == 0u) { xcd_barrier_complete(bar, b.x, nloc, nx); b.st[0] = nloc; b.st[1] = nx; }
        const unsigned old = xb_add(&bar[XB_XSUB(b.x)], 1u);
        const unsigned gen = old / nloc;
        if (old + 1u == (gen + 1u) * nloc) {
            __builtin_amdgcn_fence(__ATOMIC_RELEASE, "agent");
            asm volatile("s_waitcnt vmcnt(0)" ::: "memory");
            const unsigned og = xb_add(&bar[XB_TOP], 1u);
            const unsigned tg = og / nx;
            if (og + 1u == (tg + 1u) * nx) xb_add(&bar[XB_TOPGEN], 1u);
            else XB_SPIN(xb_ld(&bar[XB_TOPGEN]) == tg, bar);
            __builtin_amdgcn_fence(__ATOMIC_ACQUIRE, "agent");
            xb_add(&bar[XB_XGEN(b.x)], 1u);
            asm volatile("s_waitcnt vmcnt(0)" ::: "memory");
        } else {
            XB_SPIN(xb_ld(&bar[XB_XGEN(b.x)]) == gen, bar);
            __builtin_amdgcn_fence(__ATOMIC_ACQUIRE, "agent");
            asm volatile("s_waitcnt vmcnt(0)" ::: "memory");
        }
    }
    __syncthreads();
}

struct GridSync { const XcdBarrier* b; __device__ __forceinline__ void operator()() const { xcd_barrier(*b); } };

struct Args { const float* in[26]; float* out; unsigned char* ws; int ph_lo, ph_hi; };
struct Frame {
    LAS unsigned char* lds; int tid, lane, wave, vcu, G;
};
#define DPP_ROR_F(x, c) __builtin_bit_cast(float, __builtin_amdgcn_mov_dpp(__builtin_bit_cast(int, (x)), (c), 0xf, 0xf, true))
__device__ __forceinline__ float rl_f(float x, int l) { return __builtin_bit_cast(float, __builtin_amdgcn_readlane(__builtin_bit_cast(int, x), l)); }
__device__ __forceinline__ float wave_sum_dpp(float x) { x += DPP_ROR_F(x, 0x128); x += DPP_ROR_F(x, 0x124); x += DPP_ROR_F(x, 0x122); x += DPP_ROR_F(x, 0x121);
    return (rl_f(x, 0) + rl_f(x, 16)) + (rl_f(x, 32) + rl_f(x, 48)); }
__device__ __forceinline__ float wave_max_dpp(float x) { x = fmaxf(x, DPP_ROR_F(x, 0x128)); x = fmaxf(x, DPP_ROR_F(x, 0x124)); x = fmaxf(x, DPP_ROR_F(x, 0x122)); x = fmaxf(x, DPP_ROR_F(x, 0x121));
    return fmaxf(fmaxf(rl_f(x, 0), rl_f(x, 16)), fmaxf(rl_f(x, 32), rl_f(x, 48))); }
__device__ __forceinline__ float wave_sum(float v) {
#pragma unroll
    for (int o = 1; o < 64; o <<= 1) v += __shfl_xor(v, o);
    return v;
}
__device__ __forceinline__ float wave_max(float v) {
#pragma unroll
    for (int o = 1; o < 64; o <<= 1) v = fmaxf(v, __shfl_xor(v, o));
    return v;
}

__device__ const unsigned char T5B[128] = {0,1,2,3,4,5,6,7,8,9,10,11,12,13,14,15,16,16,16,17,17,18,18,18,19,19,19,20,20,20,20,21,21,21,21,22,22,22,22,22,23,23,23,23,23,23,24,24,24,24,24,24,25,25,25,25,25,25,25,26,26,26,26,26,26,26,26,27,27,27,27,27,27,27,27,27,27,28,28,28,28,28,28,28,28,28,28,29,29,29,29,29,29,29,29,29,29,29,29,30,30,30,30,30,30,30,30,30,30,30,30,30,30,31,31,31,31,31,31,31,31,31,31,31,31,31,31,31};
__device__ __forceinline__ float gelu_tanh(float x) {
    const float y = 0.7978845608028654f * (x + 0.044715f * x * x * x);
    const float e = __builtin_amdgcn_exp2f(-2.0f * 1.4426950408889634f * fabsf(y));
    const float th = (1.0f - e) * __builtin_amdgcn_rcpf(1.0f + e);
    return 0.5f * x * (1.0f + (y < 0.f ? -th : th));
}
typedef short bf16x8_t __attribute__((ext_vector_type(8)));
typedef float f32x16 __attribute__((ext_vector_type(16)));
typedef unsigned u32x2 __attribute__((ext_vector_type(2)));
constexpr int NSEG = 16, LSEG = SEQ / NSEG;
constexpr int SSMC_STRIDE = 2304;
constexpr int HS_ROWB = 272, HS_BYTES = 32 * HS_ROWB;
constexpr int LDS_HS = 0, LDS_TAB = NWAVES * HS_BYTES, TAB_N = 192;
__device__ __forceinline__ int crow(int r, int hi) { return (r & 3) + 8 * (r >> 2) + 4 * hi; }

__device__ __forceinline__ void ssm_consts_item(const Args& a, int g, int lane) {
    unsigned* tb = (unsigned*)(a.ws + WS_SSMC) + (size_t)g * SSMC_STRIDE;
    const float dt = expf(a.in[11][g]);
    auto disc = [&](int p, float& are, float& aim, float& cre, float& cim) {
        const float lr = fminf(a.in[9][g * 64 + p], -1e-4f), li = a.in[10][g * 64 + p];
        const float mag = expf(lr * dt); are = mag * cosf(li * dt); aim = mag * sinf(li * dt);
        const float den = lr * lr + li * li; cre = ((are - 1.0f) * lr + aim * li) / den; cim = (aim * lr - (are - 1.0f) * li) / den; };
    { float are, aim, cre, cim; disc(lane, are, aim, cre, cim);
      float pr = are, pi = aim;
#pragma unroll
      for (int i = 0; i < 8; ++i) { const float nr = pr * pr - pi * pi, ni = 2.0f * pr * pi; pr = nr; pi = ni; }
      tb[lane] = __float_as_uint(are); tb[64 + lane] = __float_as_uint(aim); tb[128 + lane] = __float_as_uint(pr); tb[192 + lane] = __float_as_uint(pi); }
#pragma unroll
    for (int ph = 0; ph < 2; ++ph) { const int p = 32 * ph + (lane & 31); float are, aim, cre, cim; disc(p, are, aim, cre, cim);
        float bre[8], bim[8];
#pragma unroll
        for (int j = 0; j < 8; ++j) { const int c = 8 * (lane >> 5) + j; const float br = a.in[12][(g * 64 + p) * 16 + c], bi = a.in[13][(g * 64 + p) * 16 + c];
            bre[j] = cre * br - cim * bi; bim[j] = cre * bi + cim * br; }
        unsigned* d0 = tb + 256 + ((0 * 2 + ph) * 64 + lane) * 4; unsigned* d1 = tb + 256 + ((1 * 2 + ph) * 64 + lane) * 4;
#pragma unroll
        for (int j = 0; j < 4; ++j) { d0[j] = pk2(bre[2 * j], bre[2 * j + 1]); d1[j] = pk2(bim[2 * j], bim[2 * j + 1]); } }
#pragma unroll
    for (int ks = 0; ks < 4; ++ks) { const int ch = lane & 15; float cv[8];
#pragma unroll
        for (int j = 0; j < 8; ++j) { const int k = 32 * ks + 8 * (lane >> 4) + j, p = k >> 1; cv[j] = (k & 1) ? -a.in[15][(g * 16 + ch) * 64 + p] : a.in[14][(g * 16 + ch) * 64 + p]; }
        unsigned* d = tb + 256 + 1024 + (ks * 64 + lane) * 4;
#pragma unroll
        for (int j = 0; j < 4; ++j) d[j] = pk2(cv[2 * j], cv[2 * j + 1]); }
}

struct SsmConsts { float are, aim; bf16x8_t BF[4]; };
__device__ __forceinline__ bf16x8_t ssm_load_af(const bf16* U, int row0, int g, int lane) { return *(const bf16x8_t*)(U + (size_t)(row0 + (lane & 31)) * SW + g * 16 + 8 * (lane >> 5)); }
__device__ __forceinline__ void ssm_x_chunk(const bf16x8_t af, const SsmConsts& C, f32x16& xar, f32x16& xbr, f32x16& xai, f32x16& xbi) {
    const f32x16 z = {};
    xar = __builtin_amdgcn_mfma_f32_32x32x16_bf16(af, C.BF[0], z, 0, 0, 0); xbr = __builtin_amdgcn_mfma_f32_32x32x16_bf16(af, C.BF[1], z, 0, 0, 0);
    xai = __builtin_amdgcn_mfma_f32_32x32x16_bf16(af, C.BF[2], z, 0, 0, 0); xbi = __builtin_amdgcn_mfma_f32_32x32x16_bf16(af, C.BF[3], z, 0, 0, 0);
#pragma unroll
    for (int i = 0; i < 16; ++i) {
        auto r = __builtin_amdgcn_permlane32_swap(__float_as_uint(xar[i]), __float_as_uint(xbr[i]), false, false); xar[i] = __uint_as_float(r[0]); xbr[i] = __uint_as_float(r[1]);
        auto q = __builtin_amdgcn_permlane32_swap(__float_as_uint(xai[i]), __float_as_uint(xbi[i]), false, false); xai[i] = __uint_as_float(q[0]); xbi[i] = __uint_as_float(q[1]); }
}
#define SSM_STEP(XR, XI) do { float t1_ = __builtin_fmaf(-C.aim, hi, (XR)), t2_ = __builtin_fmaf(C.aim, hr, (XI)); asm("" : "+v"(t1_)); asm("" : "+v"(t2_)); \
                              float nr_ = __builtin_fmaf(C.are, hr, t1_), ni_ = __builtin_fmaf(C.are, hi, t2_); asm("" : "+v"(nr_)); asm("" : "+v"(ni_)); hr = nr_; hi = ni_; } while (0)
__device__ __forceinline__ void ssm_pass_a(const Args& a, int b, int g, int s, int lane) {
    const bf16* U = (const bf16*)(a.ws + WS_U); const unsigned* tb = (const unsigned*)(a.ws + WS_SSMC) + (size_t)g * SSMC_STRIDE;
    SsmConsts C; C.are = __uint_as_float(tb[lane]); C.aim = __uint_as_float(tb[64 + lane]);
#pragma unroll
    for (int v = 0; v < 4; ++v) C.BF[v] = *(const bf16x8_t*)(tb + 256 + (v * 64 + lane) * 4);
    float hr = 0.f, hi = 0.f;
    bf16x8_t af = ssm_load_af(U, b * SEQ + s * LSEG, g, lane);
    for (int ch = 0; ch < LSEG / 32; ++ch) {
        const bf16x8_t afn = ssm_load_af(U, b * SEQ + s * LSEG + (ch + 1 < LSEG / 32 ? ch + 1 : ch) * 32, g, lane);
        f32x16 xar, xbr, xai, xbi; ssm_x_chunk(af, C, xar, xbr, xai, xbi); af = afn;
#pragma unroll
        for (int j = 0; j < 4; ++j) {
#pragma unroll
            for (int k = 0; k < 4; ++k) SSM_STEP(xar[4 * j + k], xai[4 * j + k]);
#pragma unroll
            for (int k = 0; k < 4; ++k) SSM_STEP(xbr[4 * j + k], xbi[4 * j + k]); }
    }
    float* hl = (float*)(a.ws + WS_HLOC) + ((size_t)(b * 64 + g) * NSEG + s) * 128; hl[lane] = hr; hl[64 + lane] = hi;
}
__device__ __forceinline__ u32x2 ssm_load_uw(const bf16* U, int row0, int tl, int g, int lane) { return *(const GAS u32x2*)(U + (size_t)(row0 + 16 * tl + (lane & 15)) * SW + g * 16 + 4 * (lane >> 4)); }
__device__ __forceinline__ void ssm_y_chunk(const Args& a, int row0, int g, int lane, LAS unsigned char* hs, const bf16x8_t (&CF)[4], const float (&dsk)[4], const u32x2 uw0, const u32x2 uw1) {
    bf16* G = (bf16*)(a.ws + WS_G);
    LDS_WAIT(); asm volatile("" ::: "memory");
#pragma unroll
    for (int tl = 0; tl < 2; ++tl) { f32x4 acc = {0.f, 0.f, 0.f, 0.f};
#pragma unroll
        for (int ks = 0; ks < 4; ++ks) { const bf16x8_t hf = *(const LAS bf16x8_t*)(hs + (16 * tl + (lane & 15)) * HS_ROWB + 64 * ks + 16 * (lane >> 4));
            acc = __builtin_amdgcn_mfma_f32_16x16x32_bf16(CF[ks], hf, acc, 0, 0, 0); }
        const size_t off = (size_t)(row0 + 16 * tl + (lane & 15)) * SW + g * 16 + 4 * (lane >> 4);
        const u32x2 uw = tl == 0 ? uw0 : uw1;
        const float y0 = acc[0] + dsk[0] * __uint_as_float(uw.x << 16), y1 = acc[1] + dsk[1] * __uint_as_float(uw.x & 0xffff0000u);
        const float y2 = acc[2] + dsk[2] * __uint_as_float(uw.y << 16), y3 = acc[3] + dsk[3] * __uint_as_float(uw.y & 0xffff0000u);
        u32x2 o; o.x = pg8::cvt_pk_bf16(gelu_tanh(y0), gelu_tanh(y1)); o.y = pg8::cvt_pk_bf16(gelu_tanh(y2), gelu_tanh(y3));
        *(GAS u32x2*)(G + off) = o; }
    LDS_WAIT(); asm volatile("" ::: "memory");
}
#define SSM_STEP_W(XR, XI, T) do { SSM_STEP(XR, XI); *(LAS unsigned*)(hs + (T) * HS_ROWB + 4 * lane) = pg8::cvt_pk_bf16(hr, hi); } while (0)
__device__ __forceinline__ void ssm_pass_b_prompt(const Args& a, int b, int g, int s, int lane, LAS unsigned char* hs) {
    const bf16* U = (const bf16*)(a.ws + WS_U); const unsigned* tb = (const unsigned*)(a.ws + WS_SSMC) + (size_t)g * SSMC_STRIDE;
    SsmConsts C; C.are = __uint_as_float(tb[lane]); C.aim = __uint_as_float(tb[64 + lane]);
    const float alr = __uint_as_float(tb[128 + lane]), ali = __uint_as_float(tb[192 + lane]);
#pragma unroll
    for (int v = 0; v < 4; ++v) C.BF[v] = *(const bf16x8_t*)(tb + 256 + (v * 64 + lane) * 4);
    bf16x8_t CF[4];
#pragma unroll
    for (int ks = 0; ks < 4; ++ks) CF[ks] = *(const bf16x8_t*)(tb + 256 + 1024 + (ks * 64 + lane) * 4);
    float dsk[4];
#pragma unroll
    for (int r = 0; r < 4; ++r) dsk[r] = a.in[16][g * 16 + 4 * (lane >> 4) + r];
    float hr = 0.f, hi = 0.f;
    const float* hl = (const float*)(a.ws + WS_HLOC) + (size_t)(b * 64 + g) * NSEG * 128;
    { float lre[NSEG - 1], lim[NSEG - 1];
#pragma unroll
      for (int sp = 0; sp < NSEG - 1; ++sp) { const bool on = sp < s; lre[sp] = on ? hl[sp * 128 + lane] : 0.f; lim[sp] = on ? hl[sp * 128 + 64 + lane] : 0.f; }
#pragma unroll
      for (int sp = 0; sp < NSEG - 1; ++sp) if (sp < s) { const float nr = alr * hr - ali * hi + lre[sp], ni = alr * hi + ali * hr + lim[sp]; hr = nr; hi = ni; } }
    bf16x8_t af = ssm_load_af(U, b * SEQ + s * LSEG, g, lane);
    for (int ch = 0; ch < LSEG / 32; ++ch) {
        const int row0 = b * SEQ + s * LSEG + ch * 32;
        const bf16x8_t afn = ssm_load_af(U, row0 + (ch + 1 < LSEG / 32 ? 32 : 0), g, lane);
        const u32x2 uw0 = ssm_load_uw(U, row0, 0, g, lane), uw1 = ssm_load_uw(U, row0, 1, g, lane);
        f32x16 xar, xbr, xai, xbi; ssm_x_chunk(af, C, xar, xbr, xai, xbi); af = afn;
#pragma unroll
        for (int j = 0; j < 4; ++j) {
#pragma unroll
            for (int k = 0; k < 4; ++k) SSM_STEP_W(xar[4 * j + k], xai[4 * j + k], 8 * j + k);
#pragma unroll
            for (int k = 0; k < 4; ++k) SSM_STEP_W(xbr[4 * j + k], xbi[4 * j + k], 8 * j + 4 + k); }
        ssm_y_chunk(a, row0, g, lane, hs, CF, dsk, uw0, uw1);
    }
    if (s == NSEG - 1) { a.out[O_PRE + (size_t)(b * 64 + g) * 64 + lane] = hr; a.out[O_PIM + (size_t)(b * 64 + g) * 64 + lane] = hi; }
}
__device__ __forceinline__ void ssm_sample_item(const Args& a, int n8, int g, int lane, LAS unsigned char* hs) {
    const bf16* U = (const bf16*)(a.ws + WS_U); const unsigned* tb = (const unsigned*)(a.ws + WS_SSMC) + (size_t)g * SSMC_STRIDE;
    SsmConsts C; C.are = __uint_as_float(tb[lane]); C.aim = __uint_as_float(tb[64 + lane]);
#pragma unroll
    for (int v = 0; v < 4; ++v) C.BF[v] = *(const bf16x8_t*)(tb + 256 + (v * 64 + lane) * 4);
    bf16x8_t CF[4];
#pragma unroll
    for (int ks = 0; ks < 4; ++ks) CF[ks] = *(const bf16x8_t*)(tb + 256 + 1024 + (ks * 64 + lane) * 4);
    float dsk[4];
#pragma unroll
    for (int r = 0; r < 4; ++r) dsk[r] = a.in[16][g * 16 + 4 * (lane >> 4) + r];
    const int row0 = MP + n8 * 32;
    const u32x2 uw0 = ssm_load_uw(U, row0, 0, g, lane), uw1 = ssm_load_uw(U, row0, 1, g, lane);
    f32x16 xar, xbr, xai, xbi; ssm_x_chunk(ssm_load_af(U, row0, g, lane), C, xar, xbr, xai, xbi);
    float h0r[8], h0i[8];
#pragma unroll
    for (int q = 0; q < 8; ++q) { const size_t si = (size_t)((n8 * 8 + q) * 64 + g) * 64 + lane; h0r[q] = a.in[2][si]; h0i[q] = a.in[3][si]; }
#pragma unroll
    for (int j = 0; j < 4; ++j) {
        { float hr = h0r[2 * j], hi = h0i[2 * j];
#pragma unroll
          for (int k = 0; k < 4; ++k) SSM_STEP_W(xar[4 * j + k], xai[4 * j + k], 8 * j + k);
          const size_t so = (size_t)((n8 * 8 + 2 * j) * 64 + g) * 64 + lane; a.out[O_SRE + so] = hr; a.out[O_SIM + so] = hi; }
        { float hr = h0r[2 * j + 1], hi = h0i[2 * j + 1];
#pragma unroll
          for (int k = 0; k < 4; ++k) SSM_STEP_W(xbr[4 * j + k], xbi[4 * j + k], 8 * j + 4 + k);
          const size_t so = (size_t)((n8 * 8 + 2 * j + 1) * 64 + g) * 64 + lane; a.out[O_SRE + so] = hr; a.out[O_SIM + so] = hi; }
    }
    ssm_y_chunk(a, row0, g, lane, hs, CF, dsk, uw0, uw1);
}

__device__ __forceinline__ void attn_prompt_item(const Args& a, int b, int h, int qt, int lane, const LAS float* tab) {
    const bf16* Q = (const bf16*)(a.ws + WS_Q); const bf16* KB = (const bf16*)(a.ws + WS_KB); const bf16* VT = (const bf16*)(a.ws + WS_VT); bf16* O = (bf16*)(a.ws + WS_O);
    const int kvh = h >> 2, lq = lane & 31, hh = lane >> 5, t0 = 32 * qt;
    const size_t rowq = (size_t)b * SEQ + t0 + lq;
    bf16x8_t qf[4];
#pragma unroll
    for (int ks = 0; ks < 4; ++ks) qf[ks] = __builtin_nontemporal_load((const GAS bf16x8_t*)(Q + rowq * SW + h * 64 + 16 * ks + 8 * hh));
    f32x16 S[5]; float mx = -1e30f;
    const LAS float* th = tab + h * TAB_N;
    bf16x8_t kf[5][4];
#pragma unroll
    for (int i = 0; i < 5; ++i) { const int ktile = qt - 4 + i; const int kt0 = 32 * (ktile >= 0 ? ktile : 0);
        const bf16* kp = KB + ((size_t)((b * 4 + kvh) * (SEQ / 32) + (kt0 >> 5))) * 2048 + lane * 8;
#pragma unroll
        for (int ks = 0; ks < 4; ++ks) kf[i][ks] = *(const bf16x8_t*)(kp + 512 * ks); }
#pragma unroll
    for (int i = 0; i < 5; ++i) {
        const int ktile = qt - 4 + i; const bool tv = ktile >= 0; const int kt0 = 32 * (tv ? ktile : 0);
        f32x16 acc = {};
#pragma unroll
        for (int ks = 0; ks < 4; ++ks) acc = __builtin_amdgcn_mfma_f32_32x32x16_bf16(kf[i][ks], qf[ks], acc, 0, 0, 0);
        const int dbase = (t0 - kt0) + lq - 4 * hh + 32;
#pragma unroll
        for (int r = 0; r < 16; ++r) { const float bv = tv ? th[dbase - (r & 3) - 8 * (r >> 2)] : -1e30f; acc[r] += bv; mx = fmaxf(mx, acc[r]); }
        S[i] = acc;
    }
    bf16x8_t vfr[5][2][2];
#pragma unroll
    for (int i = 0; i < 5; ++i) { const int ktile = qt - 4 + i; const int kt0 = 32 * (ktile >= 0 ? ktile : 0);
        const bf16* vp = VT + ((size_t)((b * 4 + kvh) * (SEQ / 32) + (kt0 >> 5))) * 2048 + lane * 8;
#pragma unroll
        for (int s2 = 0; s2 < 2; ++s2)
#pragma unroll
            for (int db = 0; db < 2; ++db) vfr[i][s2][db] = *(const bf16x8_t*)(vp + (s2 * 2 + db) * 512); }
    { auto rr = __builtin_amdgcn_permlane32_swap(__float_as_uint(mx), __float_as_uint(mx), false, false); mx = fmaxf(__uint_as_float(rr[0]), __uint_as_float(rr[1])); }
    const float sink = a.in[20][h]; mx = fmaxf(mx, sink);
    const float L2E = 1.4426950408889634f, mb = -mx * L2E; float sum = 0.f;
#pragma unroll
    for (int i = 0; i < 5; ++i)
#pragma unroll
        for (int r = 0; r < 16; ++r) { const float p = __builtin_amdgcn_exp2f(S[i][r] * L2E + mb); S[i][r] = p; sum += p; }
    { auto rr = __builtin_amdgcn_permlane32_swap(__float_as_uint(sum), __float_as_uint(sum), false, false); sum = __uint_as_float(rr[0]) + __uint_as_float(rr[1]); }
    const float inv = 1.0f / (sum + __builtin_amdgcn_exp2f(sink * L2E + mb));
    f32x16 o0 = {}, o1 = {};
#pragma unroll
    for (int i = 0; i < 5; ++i) {
#pragma unroll
        for (int s2 = 0; s2 < 2; ++s2) {
            pg8::u32x4 pw; pw.x = pg8::cvt_pk_bf16(S[i][8 * s2 + 0], S[i][8 * s2 + 1]); pw.y = pg8::cvt_pk_bf16(S[i][8 * s2 + 2], S[i][8 * s2 + 3]);
            pw.z = pg8::cvt_pk_bf16(S[i][8 * s2 + 4], S[i][8 * s2 + 5]); pw.w = pg8::cvt_pk_bf16(S[i][8 * s2 + 6], S[i][8 * s2 + 7]);
            const bf16x8_t pf = __builtin_bit_cast(bf16x8_t, pw);
#pragma unroll
            for (int db = 0; db < 2; ++db) {
                const bf16x8_t vf = vfr[i][s2][db];
                if (db == 0) o0 = __builtin_amdgcn_mfma_f32_32x32x16_bf16(vf, pf, o0, 0, 0, 0); else o1 = __builtin_amdgcn_mfma_f32_32x32x16_bf16(vf, pf, o1, 0, 0, 0);
            } } }
    bf16* op = O + rowq * SW + h * 64 + 4 * hh;
#pragma unroll
    for (int gq = 0; gq < 4; ++gq) {
        u32x2 w0; w0.x = pg8::cvt_pk_bf16(o0[4 * gq] * inv, o0[4 * gq + 1] * inv); w0.y = pg8::cvt_pk_bf16(o0[4 * gq + 2] * inv, o0[4 * gq + 3] * inv);
        u32x2 w1; w1.x = pg8::cvt_pk_bf16(o1[4 * gq] * inv, o1[4 * gq + 1] * inv); w1.y = pg8::cvt_pk_bf16(o1[4 * gq + 2] * inv, o1[4 * gq + 3] * inv);
        *(GAS u32x2*)(op + 8 * gq) = w0; *(GAS u32x2*)(op + 32 + 8 * gq) = w1; }
}
__device__ __forceinline__ void attn_sample_item(const Args& a, int n, int h, int lane_in, const LAS float* tab, LAS unsigned char* ws_l) {
    int lane = lane_in; asm volatile("" : "+v"(lane));
    const bf16* Q = (const bf16*)(a.ws + WS_Q); const float* KF = (const float*)(a.ws + WS_KF); const float* VF = (const float*)(a.ws + WS_VF); bf16* O = (bf16*)(a.ws + WS_O);
    const int kvh = h >> 2; const size_t row0 = (size_t)MP + n * 4;
    LAS float* ps = (LAS float*)ws_l;
    const LAS float* th = tab + h * TAB_N;
    { const int k4 = lane >> 4, c = lane & 15;
      f32x4 qv[4];
#pragma unroll
      for (int i = 0; i < 4; ++i) { const u32x2 w = *(const GAS u32x2*)(Q + (row0 + i) * SW + h * 64 + 4 * c);
          qv[i] = (f32x4){__uint_as_float(w.x << 16), __uint_as_float(w.x & 0xffff0000u), __uint_as_float(w.y << 16), __uint_as_float(w.y & 0xffff0000u)}; }
#define ROWSUM(x) do { x += __builtin_bit_cast(float, __builtin_amdgcn_mov_dpp(__builtin_bit_cast(int, x), 0x128, 0xf, 0xf, true)); asm("" : "+v"(x)); x += __builtin_bit_cast(float, __builtin_amdgcn_mov_dpp(__builtin_bit_cast(int, x), 0x124, 0xf, 0xf, true)); asm("" : "+v"(x)); \
                       x += __builtin_bit_cast(float, __builtin_amdgcn_mov_dpp(__builtin_bit_cast(int, x), 0x122, 0xf, 0xf, true)); asm("" : "+v"(x)); x += __builtin_bit_cast(float, __builtin_amdgcn_mov_dpp(__builtin_bit_cast(int, x), 0x121, 0xf, 0xf, true)); asm("" : "+v"(x)); } while (0)
      const __amdgpu_buffer_rsrc_t krs = __builtin_amdgcn_make_buffer_rsrc((void*)(a.in[4] + (size_t)n * 128 * 256), (short)0, 128 * 256 * 4, 0x00020000);
      const unsigned kvo = (unsigned)((k4 * 256 + kvh * 64 + 4 * c) * 4);
      pg8::u32x4 kq[33];
#pragma unroll
      for (int u = 0; u < 32; ++u) kq[u] = __builtin_amdgcn_raw_buffer_load_b128(krs, kvo, u * 4096, 0);
      kq[32] = __builtin_bit_cast(pg8::u32x4, *(const GAS f32x4*)(KF + (row0 + k4) * KVW + kvh * 64 + 4 * c));
#pragma unroll
      for (int u = 0; u < 33; ++u) { const int key = 4 * u + k4; const f32x4 kv = __builtin_bit_cast(f32x4, kq[u]);
          float s0 = qv[0].x * kv.x + qv[0].y * kv.y + qv[0].z * kv.z + qv[0].w * kv.w, s1 = qv[1].x * kv.x + qv[1].y * kv.y + qv[1].z * kv.z + qv[1].w * kv.w;
          float s2 = qv[2].x * kv.x + qv[2].y * kv.y + qv[2].z * kv.z + qv[2].w * kv.w, s3 = qv[3].x * kv.x + qv[3].y * kv.y + qv[3].z * kv.z + qv[3].w * kv.w;
          ROWSUM(s0); ROWSUM(s1); ROWSUM(s2); ROWSUM(s3);
          const int ib = 160 - key;
          if (c == 0) *(LAS f32x4*)(ps + 4 * key) = (f32x4){s0 + th[ib], s1 + th[ib + 1], s2 + th[ib + 2], s3 + th[ib + 3]}; }
      asm volatile("" ::: "memory");
#undef ROWSUM
    }
    __builtin_amdgcn_sched_barrier(0);
    const __amdgpu_buffer_rsrc_t vrs = __builtin_amdgcn_make_buffer_rsrc((void*)(a.in[5] + (size_t)n * 128 * 256), (short)0, 128 * 256 * 4, 0x00020000);
    const unsigned vvo = (unsigned)((kvh * 64 + lane) * 4);
    float vv[132];
#pragma unroll
    for (int j = 0; j < 128; ++j) vv[j] = __uint_as_float(__builtin_amdgcn_raw_buffer_load_b32(vrs, vvo, j * 1024, 0));
#pragma unroll
    for (int j = 128; j < 132; ++j) vv[j] = VF[(row0 + (j - 128)) * KVW + kvh * 64 + lane];
    __builtin_amdgcn_sched_barrier(0);
    LDS_WAIT(); asm volatile("" ::: "memory");
    const f32x4 NEG4 = {-1e30f, -1e30f, -1e30f, -1e30f};
    f32x4 sA = *(const LAS f32x4*)(ps + 4 * lane), sB = *(const LAS f32x4*)(ps + 4 * (64 + lane)), sC = (lane < 4) ? *(const LAS f32x4*)(ps + 4 * (128 + (lane & 3))) : NEG4;
    LDS_WAIT(); asm volatile("" ::: "memory");
    const float sink = a.in[20][h], L2E = 1.4426950408889634f;
    f32x4 inv;
#pragma unroll
    for (int i = 0; i < 4; ++i) {
        const float mx = fmaxf(wave_max_dpp(fmaxf(fmaxf(sA[i], sB[i]), sC[i])), sink), mb = -mx * L2E;
        const float e0 = __builtin_amdgcn_exp2f(sA[i] * L2E + mb), e1 = __builtin_amdgcn_exp2f(sB[i] * L2E + mb), e2 = __builtin_amdgcn_exp2f(sC[i] * L2E + mb);
        sA[i] = e0; sB[i] = e1; sC[i] = e2;
        inv[i] = 1.0f / (wave_sum_dpp(e0 + e1 + e2) + __builtin_amdgcn_exp2f(sink * L2E + mb));
    }
    *(LAS f32x4*)(ps + 4 * lane) = sA * inv; *(LAS f32x4*)(ps + 4 * (64 + lane)) = sB * inv; if (lane < 8) *(LAS f32x4*)(ps + 4 * (128 + lane)) = sC * inv;
    LDS_WAIT(); asm volatile("" ::: "memory");
    float o0 = 0.f, o1 = 0.f, o2 = 0.f, o3 = 0.f;
#pragma unroll
    for (int j = 0; j < 132; ++j) { const float v = vv[j];   const f32x4 p = *(const LAS f32x4*)(ps + 4 * j); o0 += p.x * v; o1 += p.y * v; o2 += p.z * v; o3 += p.w * v; }
    O[(row0 + 0) * SW + h * 64 + lane] = (bf16)f2bf(o0); O[(row0 + 1) * SW + h * 64 + lane] = (bf16)f2bf(o1);
    O[(row0 + 2) * SW + h * 64 + lane] = (bf16)f2bf(o2); O[(row0 + 3) * SW + h * 64 + lane] = (bf16)f2bf(o3);
    LDS_WAIT(); asm volatile("" ::: "memory");
}
#ifndef DUP_SUB
#define DUP_SUB 0
#endif
__device__ __forceinline__ void p2a_phase(const Frame& F, const Args& a) {
    unsigned char* ws = a.ws;
    const int gw = F.vcu * NWAVES + F.wave, NGW = F.G * NWAVES;
    LAS float* tab = (LAS float*)(F.lds + LDS_TAB);
    for (int i = F.tid; i < NH * TAB_N; i += NWAVES * 64) { const int h = i / TAB_N, dist = i % TAB_N - 32; tab[i] = (dist >= 0 && dist < WIN) ? a.in[6][T5B[dist] * 16 + h] : -1e30f; }
    for (int rp_ = 0; rp_ < (DUP_SUB == 1 ? 2 : 1); ++rp_)
    for (int it = gw; it < 2 * NGRP * (NSEG - 1); it += NGW) { const int bg = it / (NSEG - 1), sgm = it % (NSEG - 1); ssm_pass_a(a, bg / NGRP, bg % NGRP, sgm, F.lane); }
    LDS_WAIT(); __syncthreads();
    for (int rp_ = 0; rp_ < (DUP_SUB == 2 ? 2 : 1); ++rp_)
    for (int it = gw; it < 2 * NH * (SEQ / 32); it += NGW) attn_prompt_item(a, it / (NH * (SEQ / 32)), (it / (SEQ / 32)) % NH, it % (SEQ / 32), F.lane, tab);
    { LAS unsigned char* wsl = F.lds + LDS_HS + F.wave * HS_BYTES;
      for (int rp_ = 0; rp_ < (DUP_SUB == 3 ? 2 : 1); ++rp_)
      for (int it = gw; it < DECB * NH; it += NGW) attn_sample_item(a, it / NH, it % NH, F.lane, tab, wsl); }
    const float* KF = (const float*)(ws + WS_KF); const float* VF = (const float*)(ws + WS_VF);
    for (int rp_ = 0; rp_ < (DUP_SUB == 4 ? 2 : 1); ++rp_)
    for (int r0 = gw; r0 < (DECB + 2) * 128 * 2; r0 += 4 * NGW) {
        f32x4 val[4]; float* dst[4];
#pragma unroll
        for (int u = 0; u < 4; ++u) { int rr = r0 + u * NGW; if (rr >= (DECB + 2) * 128 * 2) rr = r0;
            const int kv = rr & 1, row = rr >> 1, n = row >> 7, j = row & 127; const float* src;
            if (n < DECB) { src = (j < 124) ? a.in[4 + kv] + (size_t)(n * 128 + j + 4) * 256 : (kv ? VF : KF) + (size_t)(MP + n * 4 + (j - 124)) * KVW; dst[u] = a.out + (kv ? O_SV : O_SK) + (size_t)row * 256; }
            else { const int b = n - DECB; src = (kv ? VF : KF) + (size_t)(b * SEQ + SEQ - 128 + j) * KVW; dst[u] = a.out + (kv ? O_PV : O_PK) + (size_t)(b * 128 + j) * 256; }
            val[u] = __builtin_nontemporal_load((const GAS f32x4*)(src + 4 * F.lane)); }
#pragma unroll
        for (int u = 0; u < 4; ++u) __builtin_nontemporal_store(val[u], (GAS f32x4*)(dst[u] + 4 * F.lane));
    }
}
__device__ __forceinline__ void p2b_phase(const Frame& F, const Args& a) {
    const int gw = F.vcu * NWAVES + F.wave, NGW = F.G * NWAVES;
    LAS unsigned char* hs = F.lds + LDS_HS + F.wave * HS_BYTES;
    for (int it = gw; it < 2 * NGRP * NSEG; it += NGW) { const int bg = it / NSEG, sgm = it % NSEG; ssm_pass_b_prompt(a, bg / NGRP, bg % NGRP, sgm, F.lane, hs); }
    for (int it = gw; it < (DECB / 8) * NGRP; it += NGW) ssm_sample_item(a, it / NGRP, it % NGRP, F.lane, hs);
}
struct P0Item { const float* W; const float* ksc; bf16* WT; int K, N, k0, n0, drow0; };
template <bool NT = false> __device__ __forceinline__ void p0_load(const P0Item& d, f32x4 (&v)[16], float (&kv)[16], int lane) {
    const int r = lane >> 4, c = lane & 15;
#pragma unroll
    for (int j = 0; j < 16; ++j) { const int k = d.k0 + 8 * (j >> 1) + 2 * r + (j & 1); const GAS f32x4* p = (const GAS f32x4*)(d.W + (size_t)k * d.N + d.n0 + 4 * c); v[j] = NT ? __builtin_nontemporal_load(p) : *p; }
    if (d.ksc) {
#pragma unroll
        for (int j = 0; j < 16; ++j) kv[j] = d.ksc[d.k0 + 8 * (j >> 1) + 2 * r + (j & 1)]; }
}
template <bool NT = false> __device__ __forceinline__ void p0_finish(const P0Item& d, f32x4 (&v)[16], const float (&kv)[16], LAS unsigned* scr, int lane) {
    const int r = lane >> 4, c = lane & 15;
    if (d.ksc) {
#pragma unroll
        for (int j = 0; j < 16; ++j) v[j] = v[j] * kv[j]; }
#pragma unroll
    for (int m = 0; m < 8; ++m)
#pragma unroll
        for (int e = 0; e < 4; ++e) { const int n = 4 * c + e; scr[n * 36 + 4 * (m ^ ((n >> 3) & 7)) + r] = pg8::cvt_pk_bf16(v[2 * m][e], v[2 * m + 1][e]); }
    LDS_WAIT(); asm volatile("" ::: "memory");
    const int q = lane & 7;
#pragma unroll
    for (int i = 0; i < 8; ++i) { const int nn = (lane >> 3) + 8 * i; const v4u w = *(const LAS v4u*)(scr + nn * 36 + 4 * (q ^ ((nn >> 3) & 7)));
        GAS v4u* po = (GAS v4u*)(d.WT + (size_t)(d.drow0 + nn) * d.K + d.k0 + 8 * q); if (NT) __builtin_nontemporal_store(w, po); else *po = w; }
    LDS_WAIT(); asm volatile("" ::: "memory");
}
template <bool NT = false, bool NTL = NT> __device__ __forceinline__ void p0_transpose_item(const float* W, int K, int N, const float* ksc, bf16* WT, int k0, int n0, int drow0, LAS unsigned* scr, int lane) {
    const P0Item d{W, ksc, WT, K, N, k0, n0, drow0}; f32x4 v[16]; float kv[16]; p0_load<NTL>(d, v, kv, lane); p0_finish<NT>(d, v, kv, scr, lane);
}
__device__ __forceinline__ int il_row(int j, int h) { return (j >> 7) * 256 + h * 128 + (j & 127); }

constexpr int I_IN_ITEMS = (D / 64) * (NIN / 64), I_GV_ITEMS = (SW / 64) * (D / 64), I_OUT_ITEMS = (D / 64) * (D / 64), I_FI_ITEMS = (D / 64) * (2 * FF / 64), I_FO_ITEMS = (FF / 64) * (D / 64);
constexpr int I_MID_ITEMS = 3 * I_GV_ITEMS + I_OUT_ITEMS + I_FI_ITEMS, N_ITEMS = I_IN_ITEMS + I_MID_ITEMS + I_FO_ITEMS;
__device__ __forceinline__ int ffo_late_idle(int G) { pg8::StaticOrder S; S.init(M, 2 * FF, D, G, 0, 8); const int idle = (S.T.r == 0) ? S.T.R * G - S.nwg : 0; return idle >= 32 ? idle : 0; }
#ifndef P1_NG
#define P1_NG 224
#endif
#ifndef CONV1
#define CONV1 8192
#endif
__device__ __forceinline__ int p1_gemm_wgs(int G) { return (G == 256) ? P1_NG : G; }
__device__ __forceinline__ int p1_conv_items(int G) { return (p1_gemm_wgs(G) < G) ? (CONV1 < I_MID_ITEMS ? CONV1 : I_MID_ITEMS) : 0; }
__device__ __forceinline__ void p0_item(const Args& a, int it, LAS unsigned* scr, int lane) {
    unsigned char* ws = a.ws; constexpr int I_IN = I_IN_ITEMS, I_GV = I_GV_ITEMS, I_OUT = I_OUT_ITEMS, I_FI = I_FI_ITEMS;
    int r = it;
    if (r < I_IN) { const int nb = NIN / 64, kb = r / nb, n0 = 64 * (r % nb); p0_transpose_item<false, true>(a.in[8], D, NIN, a.in[7], (bf16*)(ws + WS_WIN), 64 * kb, n0, n0, scr, lane); return; } r -= I_IN;
    if (r < I_GV) { const int nb = D / 64, kb = r / nb, n0 = 64 * (r % nb); p0_transpose_item<false, true>(a.in[17], SW, D, nullptr, (bf16*)(ws + WS_WGB), 64 * kb, n0, il_row(n0, 0), scr, lane); return; } r -= I_GV;
    if (r < I_GV) { const int nb = D / 64, kb = r / nb, n0 = 64 * (r % nb); p0_transpose_item<false, true>(a.in[18], SW, D, nullptr, (bf16*)(ws + WS_WGB), 64 * kb, n0, il_row(n0, 1), scr, lane); return; } r -= I_GV;
    if (r < I_GV) { const int nb = D / 64, kb = r / nb, n0 = 64 * (r % nb); p0_transpose_item<false, true>(a.in[19], SW, D, nullptr, (bf16*)(ws + WS_WGB), 64 * kb, n0, 4096 + n0, scr, lane); return; } r -= I_GV;
    if (r < I_OUT) { const int nb = D / 64, kb = r / nb, n0 = 64 * (r % nb); p0_transpose_item<false, true>(a.in[21], D, D, nullptr, (bf16*)(ws + WS_WOUT), 64 * kb, n0, n0, scr, lane); return; } r -= I_OUT;
    if (r < I_FI) { const int nb = 2 * FF / 64, kb = r / nb, n0 = 64 * (r % nb); const int dr = (n0 < FF) ? il_row(n0, 0) : il_row(n0 - FF, 1);
        p0_transpose_item<false, true>(a.in[23], D, 2 * FF, a.in[22], (bf16*)(ws + WS_WFI), 64 * kb, n0, dr, scr, lane); return; } r -= I_FI;
    { const int nb = D / 64, kb = r / nb, n0 = 64 * (r % nb); p0_transpose_item<false, true>(a.in[24], FF, D, nullptr, (bf16*)(ws + WS_WFO), 64 * kb, n0, n0, scr, lane); }
}
__device__ __forceinline__ void p0_prologue(const Frame& F, const Args& a) {
    unsigned char* ws = a.ws;
    LAS unsigned* scr = (LAS unsigned*)(F.lds + RING_OFF + F.wave * 16384);
    const int gw = F.vcu * NWAVES + F.wave, NGW = F.G * NWAVES;
    if (gw < NGRP) ssm_consts_item(a, gw, F.lane);
    const int cv = p1_conv_items(F.G), folate = ffo_late_idle(F.G) ? I_FO_ITEMS : 0;
    const int nmid = I_MID_ITEMS - cv, n0 = I_IN_ITEMS + nmid + (I_FO_ITEMS - folate);
    for (int j = gw; j < n0; j += NGW) p0_item(a, j < I_IN_ITEMS ? j : (j < I_IN_ITEMS + nmid ? j + cv : j + cv + folate), scr, F.lane);
    bf16* XB = (bf16*)(ws + WS_XB); float* rs1 = (float*)(ws + WS_RS1);
    auto xrow_of = [&](int m) -> const GAS f32x4* { const float* xrow = (m < MP) ? a.in[0] + (size_t)m * D : a.in[1] + (size_t)(m - MP) * D; return (const GAS f32x4*)xrow + F.lane; };
    for (int m0 = F.vcu * 32 + F.wave * 4; m0 < M; m0 += F.G * 32) {
        f32x4 v[8], w[8];
        { const GAS f32x4* xr = xrow_of(m0);
#pragma unroll
          for (int j = 0; j < 8; ++j) v[j] = __builtin_nontemporal_load(xr + 64 * j); }
#pragma unroll
        for (int u = 0; u < 4; ++u) { const int m = m0 + u;
            if (u < 3) { const GAS f32x4* xn = xrow_of(m + 1);
#pragma unroll
                for (int j = 0; j < 8; ++j) w[j] = __builtin_nontemporal_load(xn + 64 * j); }
            float s = 0.f;
#pragma unroll
            for (int j = 0; j < 8; ++j) s += (v[j].x * v[j].x + v[j].y * v[j].y) + (v[j].z * v[j].z + v[j].w * v[j].w);
            s = wave_sum_dpp(s);
            GAS unsigned long long* o8 = (GAS unsigned long long*)(XB + (size_t)m * D) + F.lane;
#pragma unroll
            for (int j = 0; j < 8; ++j) o8[64 * j] = (unsigned long long)pk2(v[j].x, v[j].y) | ((unsigned long long)pk2(v[j].z, v[j].w) << 32);
            if (F.lane == 0) rs1[m] = 1.0f / sqrtf(s * (1.0f / D) + EPS);
#pragma unroll
            for (int j = 0; j < 8; ++j) v[j] = w[j];
        }
    }
}

__device__ __forceinline__ void p7_phase(const Frame& F, const Args& a) {
    const int gw = F.vcu * NWAVES + F.wave, NGW = F.G * NWAVES;
    const float* RSS = (const float*)(a.ws + WS_RSS3); const float* gf = a.in[25]; const bf16* X2 = (const bf16*)(a.ws + WS_D);
    for (int m = gw; m < M; m += NGW) {
        const float pv = (F.lane < 32) ? RSS[((size_t)(F.lane >> 2) * M + m) * 4 + (F.lane & 3)] : 0.f;
        const GAS v4u* xr = (const GAS v4u*)(X2 + (size_t)m * D) + F.lane; v4u w[4];
#pragma unroll
        for (int j = 0; j < 4; ++j) w[j] = xr[64 * j];
        const float s = 1.0f / sqrtf(wave_sum(pv) * (1.0f / D) + EPS);
        GAS f32x4* yr = (GAS f32x4*)(a.out + (size_t)m * D); const GAS f32x4* gr = (const GAS f32x4*)gf;
#pragma unroll
        for (int j = 0; j < 4; ++j) { const int c4 = 2 * (64 * j + F.lane); pg8::f32x4 v0, v1; pg8::unpack8(__builtin_bit_cast(pg8::u32x4, w[j]), v0, v1);
            yr[c4] = v0 * s * gr[c4]; yr[c4 + 1] = v1 * s * gr[c4 + 1]; }
    }
}

#ifndef DBG_STOP
#define DBG_STOP 0
#endif
__device__ __forceinline__ void dbg_dump_bf16(const Frame& F, const Args& a, const bf16* src, int ld, int c0, int n) {
    const int gt = (F.vcu * NWAVES + F.wave) * 64 + F.lane, NGT = F.G * NWAVES * 64;
    for (size_t i = gt; i < (size_t)M * n; i += NGT) { const size_t r = i / n, j = i % n; a.out[r * D + c0 + j] = bf2f(src[r * ld + j]); }
}
__global__ void __launch_bounds__(NWAVES * 64, 2) mega_fwd(Args args) {
    extern __shared__ __attribute__((aligned(16))) unsigned char lds[];
    Frame F;
    F.lds = (LAS unsigned char*)lds;
    volatile LAS unsigned* MISC = (volatile LAS unsigned*)(F.lds + MISC_OFF);
    F.tid = threadIdx.x; F.lane = F.tid & 63; F.wave = __builtin_amdgcn_readfirstlane(F.tid >> 6);
    F.G = gridDim.x; { const int bx = blockIdx.x; F.vcu = (F.G % 8 == 0) ? (bx % 8) * (F.G / 8) + bx / 8 : bx; }
    unsigned char* ws = args.ws;
    gu32* ctl = (gu32*)(ws + WS_CTL);
    for (int u = F.tid; u < (LDS_BYTES - LDSCTL_OFF) / 4; u += NWAVES * 64) ((LAS unsigned*)(F.lds + LDSCTL_OFF))[u] = 0u;
    __syncthreads();
    const int lo = args.ph_lo, hi = args.ph_hi;
    const bool multi = (hi - lo) > 1;
    XcdBarrier bar; bar.bar = (unsigned*)(ctl + CW_BAR); bar.x = 0; bar.st = nullptr;
    if (multi) bar = xcd_barrier_post((unsigned*)(ctl + CW_BAR), MISC + 8);
#define IN(k) (lo <= (k) && (k) < hi)
#define SEAM(k) do { if (IN(k) && IN((k) + 1)) xcd_barrier(bar); } while (0)
    using namespace pg8;
#ifndef DUP_PHASE
#define DUP_PHASE -1
#endif
#define PH_BEGIN(k) if (IN(k)) { for (int rep_ = 0; rep_ < ((DUP_PHASE == (k)) ? 2 : 1); ++rep_) { if (rep_) xcd_barrier(bar);
#define PH_END(k) } SEAM(k); }
    PH_BEGIN(0) p0_prologue(F, args); PH_END(0)
    PH_BEGIN(1)
        const int ng1 = p1_gemm_wgs(F.G);
        if ((int)blockIdx.x >= ng1) {
            LAS unsigned* scr = (LAS unsigned*)(F.lds + RING_OFF + F.wave * 16384); const int cv = p1_conv_items(F.G), ncw = (F.G - ng1) * NWAVES;
            const float* w_gv0 = args.in[17]; const float* w_gv1 = args.in[18]; const float* w_gv2 = args.in[19]; const float* w_out = args.in[21]; const float* w_fi = args.in[23]; const float* k_fi = args.in[22];
            asm volatile("" : "+s"(w_gv0), "+s"(w_gv1), "+s"(w_gv2), "+s"(w_out), "+s"(w_fi), "+s"(k_fi));
            auto mid_item = [&](int k) -> P0Item {
                int r = k, sec, nb;
                if (r < I_GV_ITEMS) { sec = 1; nb = D / 64; } else { r -= I_GV_ITEMS;
                if (r < I_GV_ITEMS) { sec = 2; nb = D / 64; } else { r -= I_GV_ITEMS;
                if (r < I_GV_ITEMS) { sec = 3; nb = D / 64; } else { r -= I_GV_ITEMS;
                if (r < I_OUT_ITEMS) { sec = 4; nb = D / 64; } else { r -= I_OUT_ITEMS; sec = 5; nb = 2 * FF / 64; } } } }
                int kb = r / nb, n0 = 64 * (r - kb * nb);
                sec = __builtin_amdgcn_readfirstlane(sec); kb = __builtin_amdgcn_readfirstlane(kb); n0 = __builtin_amdgcn_readfirstlane(n0);
                P0Item d; d.k0 = 64 * kb; d.n0 = n0;
                d.W = sec == 1 ? w_gv0 : sec == 2 ? w_gv1 : sec == 3 ? w_gv2 : sec == 4 ? w_out : w_fi;
                d.ksc = sec == 5 ? k_fi : nullptr;
                d.WT = (bf16*)(ws + (sec <= 3 ? WS_WGB : sec == 4 ? WS_WOUT : WS_WFI));
                d.K = sec <= 3 ? SW : D; d.N = sec == 5 ? 2 * FF : D;
                d.drow0 = sec == 1 ? il_row(n0, 0) : sec == 2 ? il_row(n0, 1) : sec == 3 ? 4096 + n0 : sec == 4 ? n0 : ((n0 < FF) ? il_row(n0, 0) : il_row(n0 - FF, 1));
                return d; };
            f32x4 va[16], vb[16]; float ka[16], kb[16]; P0Item d0, d1;
            int k = ((int)blockIdx.x - ng1) * NWAVES + F.wave; bool h0 = k < cv;
            if (h0) { d0 = mid_item(k); p0_load<true>(d0, va, ka, F.lane); }
            while (h0) {
                const int k1 = k + ncw; const bool h1 = k1 < cv;
                if (h1) { d1 = mid_item(k1); p0_load<true>(d1, vb, kb, F.lane); }
                p0_finish<true>(d0, va, ka, scr, F.lane);
                if (!h1) break;
                k = k1 + ncw; h0 = k < cv;
                if (h0) { d0 = mid_item(k); p0_load<true>(d0, va, ka, F.lane); }
                p0_finish<true>(d1, vb, kb, scr, F.lane);
            }
        } else {
        Gemm g{(const bf16_t*)(ws + WS_XB), (const bf16_t*)(ws + WS_WIN), D}; StaticOrder S; S.init(M, NIN, D, ng1, (int)blockIdx.x, 8); S.pmul = 5;
        const TailFix tf{(unsigned char*)args.out, (unsigned*)(ctl + CW_TAIL + 0 * 8192)};
        LAS float* rs1l = (LAS float*)(F.lds + RS2L_OFF);
        { const float* rs1g = (const float*)(ws + WS_RS1); Unit uu;
          float rv[8]; bool on[8];
#pragma unroll
          for (int ui = 0; ui < 8; ++ui) { on[ui] = S.next(ui, uu); rv[ui] = rs1g[(on[ui] ? uu.pm : 0) * BM + (F.tid & (BM - 1))]; }
#pragma unroll
          for (int ui = 0; ui < 8; ++ui) if (on[ui] && F.tid < BM) rs1l[ui * BM + F.tid] = rv[ui];
          LDS_WAIT(); __syncthreads(); }
        EpiIn E{(const PG8_LAS float*)rs1l, (bf16_t*)(ws + WS_U), (bf16_t*)(ws + WS_Q), (float*)(ws + WS_KF), (float*)(ws + WS_VF), (bf16_t*)(ws + WS_GT), (bf16_t*)(ws + WS_KB), (bf16_t*)(ws + WS_VT)};
        gemm_phase<EpiIn, StaticOrder, true, true, true>(F.lds + RING_OFF, g, S, E, tf);
        }
    PH_END(1)
    PH_BEGIN(2) p2a_phase(F, args); PH_END(2)
    PH_BEGIN(3) p2b_phase(F, args); PH_END(3)
    PH_BEGIN(4)
        Gemm g{(const bf16_t*)(ws + WS_G), (const bf16_t*)(ws + WS_WGB), SW}; TripleOrder S; S.init(M, D, SW, F.G, (int)blockIdx.x, 8); const TailFix tf{(unsigned char*)args.out, (unsigned*)(ctl + CW_TAIL + 1 * 8192)};
        EpiMix E{(const bf16_t*)(ws + WS_GT), (bf16_t*)(ws + WS_T), (bf16_t*)(ws + WS_D)};
        gemm_phase<EpiMix, TripleOrder, true, true, true>(F.lds + RING_OFF, g, S, E, tf);
    PH_END(4)
    PH_BEGIN(5)
        Gemm g{(const bf16_t*)(ws + WS_D), (const bf16_t*)(ws + WS_WOUT), D}; StaticOrder S; S.init(M, D, D, F.G, (int)blockIdx.x, 8); const TailFix tf{ws + WS_T, (unsigned*)(ctl + CW_TAIL + 2 * 8192)};
        EpiRes E{nullptr, nullptr, (const bf16_t*)(ws + WS_XB), nullptr, (bf16_t*)(ws + WS_X1B), (float*)(ws + WS_RSS2)};
        gemm_phase<EpiRes, StaticOrder, true, true, true>(F.lds + RING_OFF, g, S, E, tf);
    PH_END(5)
    PH_BEGIN(6)
        Gemm g{(const bf16_t*)(ws + WS_X1B), (const bf16_t*)(ws + WS_WFI), D}; StaticOrder S; S.init(M, 2 * FF, D, F.G, (int)blockIdx.x, 8); const TailFix tf{ws + WS_D, (unsigned*)(ctl + CW_TAIL + 4 * 8192)};
        LAS float* rs2l = (LAS float*)(F.lds + RS2L_OFF);
        { const f32x4* RQ = (const f32x4*)(ws + WS_RSS2); Unit uu; const int trow = F.lane >> 1, th = F.lane & 1;
          f32x4 q[8][4]; bool on[8];
#pragma unroll
          for (int ui = 0; ui < 8; ++ui) { on[ui] = S.next(ui, uu); const f32x4* rq = RQ + (size_t)(4 * th) * M + ((on[ui] ? uu.pm : 0) * BM + F.wave * 32 + trow);
              q[ui][0] = rq[0]; q[ui][1] = rq[M]; q[ui][2] = rq[2 * (size_t)M]; q[ui][3] = rq[3 * (size_t)M]; }
#pragma unroll
          for (int ui = 0; ui < 8; ++ui) { const f32x4 t = (q[ui][0] + q[ui][1]) + (q[ui][2] + q[ui][3]); float sm = (t[0] + t[1]) + (t[2] + t[3]); sm += __shfl_xor(sm, 1);
              if (on[ui] && th == 0) rs2l[ui * BM + F.wave * 32 + trow] = 1.0f / sqrtf(sm * (1.0f / D) + EPS); }
          LDS_WAIT(); __syncthreads(); }
        EpiFfn E{(const PG8_LAS float*)rs2l, (bf16_t*)(ws + WS_ACT)};
        gemm_phase<EpiFfn, StaticOrder, true, true>(F.lds + RING_OFF, g, S, E, tf);
        { const int nid = ffo_late_idle(F.G); const int c = (int)blockIdx.x, lastn = F.G - nid;
          if (nid && c >= lastn) { LAS unsigned* scr = (LAS unsigned*)(F.lds + RING_OFF + F.wave * 16384);
              for (int r = (c - lastn) * NWAVES + F.wave; r < I_FO_ITEMS; r += nid * NWAVES) { const int nb = D / 64, kb = r / nb, n0 = 64 * (r % nb);
                  p0_transpose_item<true>(args.in[24], FF, D, nullptr, (bf16*)(ws + WS_WFO), 64 * kb, n0, n0, scr, F.lane); } } }
    PH_END(6)
    bool fused_final = false;
    if (IN(7)) {
        Gemm g{(const bf16_t*)(ws + WS_ACT), (const bf16_t*)(ws + WS_WFO), FF}; StaticOrder S; S.init(M, D, FF, F.G, (int)blockIdx.x, 8); const TailFix tf{ws + WS_C + (size_t)M * D * 2, (unsigned*)(ctl + CW_TAIL + 3 * 8192)};
        fused_final = multi && IN(8) && DUP_PHASE != 7 && S.T.R == 1 && S.T.r > 0 && S.T.s == 8;
        if (fused_final) {
            S.tfirst = true;
            EpiFinal E{(const bf16_t*)(ws + WS_X1B), (float*)(ws + WS_RSS3), args.out, args.in[25], (LAS float*)(F.lds + RS2L_OFF)};
            const GridSync gs{&bar};
            gemm_phase<EpiFinal, StaticOrder, true, true, true, GridSync>(F.lds + RING_OFF, g, S, E, tf, gs);
        } else {
            for (int rep_ = 0; rep_ < ((DUP_PHASE == 7) ? 2 : 1); ++rep_) { if (rep_) xcd_barrier(bar);
                EpiRes E{nullptr, nullptr, (const bf16_t*)(ws + WS_X1B), nullptr, (bf16_t*)(ws + WS_D), (float*)(ws + WS_RSS3)};
                gemm_phase<EpiRes, StaticOrder, true, true, true>(F.lds + RING_OFF, g, S, E, tf); }
            SEAM(7);
        }
    }
    if (!fused_final) { PH_BEGIN(8) p7_phase(F, args); PH_END(8) }
#undef IN
#undef SEAM
}

#ifndef MK_N_LAUNCHES
#define MK_N_LAUNCHES 1
#endif
extern "C" void kernel_launch(void* const* d_in, const int* in_sizes, int n_in, void* d_out, int out_size, void* d_ws, size_t ws_size, hipStream_t stream) {
    static int grid = 0;
    if (grid == 0) {
        if (n_in != 26 || (size_t)out_size != O_END || ws_size < WS_END) { fprintf(stderr, "kernel_launch: unexpected shapes: n_in %d out %d ws %zu (need %zu)\n", n_in, out_size, ws_size, (size_t)WS_END); grid = -1; return; }
        int dev = 0, cus = 0;
        if (hipGetDevice(&dev) != hipSuccess || hipDeviceGetAttribute(&cus, hipDeviceAttributeMultiprocessorCount, dev) != hipSuccess) { grid = -1; return; }
        if (hipFuncSetAttribute((const void*)mega_fwd, hipFuncAttributeMaxDynamicSharedMemorySize, LDS_BYTES) != hipSuccess) { fprintf(stderr, "kernel_launch: hipFuncSetAttribute failed\n"); grid = -1; return; }
        (void)hipGetLastError();
        grid = cus;
    }
    if (grid < 0) return;
    (void)hipMemsetAsync((char*)d_ws + WS_CTL, 0, CTL_ZERO_BYTES, stream);
    Args a{};
    for (int i = 0; i < 26; ++i) a.in[i] = (const float*)d_in[i];
    a.out = (float*)d_out; a.ws = (unsigned char*)d_ws;
    constexpr int NPH = 9;
    if (MK_N_LAUNCHES == 1) { a.ph_lo = 0; a.ph_hi = NPH; hipLaunchKernelGGL(mega_fwd, dim3(grid), dim3(NWAVES * 64), LDS_BYTES, stream, a); }
    else for (int p = 0; p < NPH; ++p) { a.ph_lo = p; a.ph_hi = p + 1; hipLaunchKernelGGL(mega_fwd, dim3(grid), dim3(NWAVES * 64), LDS_BYTES, stream, a); }
}
```
